# Optimizing an MI355X kernel written in HIP

```python
import math
import jax, jax.numpy as jnp
from jax import lax
import numpy as np

D_MODEL = 4096
BATCH = 4
SEQ = 2048
DEPTH = 1

EPS = 1e-6

MLA_HEADS = 16
QK_NOPE_DIM = 128
QK_ROPE_DIM = 64
QK_HEAD_DIM = QK_NOPE_DIM + QK_ROPE_DIM
V_HEAD_DIM = 128
Q_LORA_RANK = 1024
KV_LORA_RANK = 512
ROPE_BASE = 10000.0
Q_BLOCK = 128
MLA_WIDTH = MLA_HEADS * V_HEAD_DIM

SSM_WIDTH = D_MODEL - MLA_WIDTH
SSM_HEAD_DIM = 64
SSM_HEADS = SSM_WIDTH // SSM_HEAD_DIM
SSM_GROUPS = 8
SSM_HEADS_PER_GROUP = SSM_HEADS // SSM_GROUPS
D_STATE = 128
D_CONV = 5
CHUNK = 128
CONV_DIM = SSM_WIDTH + 2 * SSM_GROUPS * D_STATE

MIX_WIDTH = MLA_WIDTH + SSM_WIDTH

IN_SIZES = (Q_LORA_RANK, KV_LORA_RANK, QK_ROPE_DIM, SSM_WIDTH, CONV_DIM, SSM_HEADS, SSM_HEADS)
IN_WIDTH = sum(IN_SIZES)
IN_SPLITS = tuple(int(v) for v in np.cumsum(IN_SIZES)[:-1])

PEER_HEADS = 8
N_KEYS = 128
N_EXPERTS = N_KEYS * N_KEYS
PEER_TOPK = 16
PEER_QDIM = 256
PEER_TOKEN_BLOCK = 128

kernel_name = "hymba_mla_ssd_peer_encoder_layer"


def rms_norm(x, gain):
    xf = x.astype(jnp.float32)
    y = xf * lax.rsqrt(jnp.mean(xf * xf, axis=-1, keepdims=True) + EPS)
    return (y * gain.astype(jnp.float32)).astype(x.dtype)


def apply_rope(t, positions):
    half = QK_ROPE_DIM // 2
    inv_freq = ROPE_BASE ** (-jnp.arange(half, dtype=jnp.float32) / half)
    ang = positions.astype(jnp.float32)[..., None] * inv_freq
    cos = jnp.cos(ang)[:, :, None, :]
    sin = jnp.sin(ang)[:, :, None, :]
    tf = t.astype(jnp.float32)
    t1, t2 = tf[..., :half], tf[..., half:]
    return jnp.concatenate([t1 * cos - t2 * sin, t1 * sin + t2 * cos], axis=-1).astype(t.dtype)


def mla_mixer(c_q, c_kv, k_rope, positions, q_a_norm, w_uq, kv_a_norm, w_ukv, q_norm, k_norm, attn_out_norm):
    b, s, _ = c_q.shape
    q = (rms_norm(c_q, q_a_norm) @ w_uq).reshape(b, s, MLA_HEADS, QK_HEAD_DIM)
    kv = (rms_norm(c_kv, kv_a_norm) @ w_ukv).reshape(b, s, MLA_HEADS, QK_NOPE_DIM + V_HEAD_DIM)
    k_nope, v = kv[..., :QK_NOPE_DIM], kv[..., QK_NOPE_DIM:]
    k = jnp.concatenate(
        [k_nope, jnp.broadcast_to(k_rope[:, :, None, :], (b, s, MLA_HEADS, QK_ROPE_DIM))], axis=-1)
    q = rms_norm(q, q_norm)
    k = rms_norm(k, k_norm)
    q = jnp.concatenate([q[..., :QK_NOPE_DIM], apply_rope(q[..., QK_NOPE_DIM:], positions)], axis=-1)
    k = jnp.concatenate([k[..., :QK_NOPE_DIM], apply_rope(k[..., QK_NOPE_DIM:], positions)], axis=-1)
    scale = QK_HEAD_DIM ** -0.5
    n_blk = s // Q_BLOCK
    q_blocks = jnp.moveaxis(q.reshape(b, n_blk, Q_BLOCK, MLA_HEADS, QK_HEAD_DIM), 1, 0)

    def attend(q_blk):
        sc = jnp.einsum("bqhd,bkhd->bhqk", q_blk, k, preferred_element_type=jnp.float32) * scale
        p = jax.nn.softmax(sc, axis=-1)
        return jnp.einsum("bhqk,bkhd->bqhd", p.astype(v.dtype), v)

    o = lax.map(attend, q_blocks)
    o = jnp.moveaxis(o, 0, 1).reshape(b, s, MLA_HEADS, V_HEAD_DIM)
    o = rms_norm(o, attn_out_norm)
    return o.reshape(b, s, MLA_WIDTH)


def ssd_scan(xs, dt_raw, a_log, dt_bias, bs, cs):
    b, s, g, r, p = xs.shape
    nc = s // CHUNK
    dt = jax.nn.softplus(dt_raw.astype(jnp.float32) + dt_bias.astype(jnp.float32)).reshape(b, s, g, r)
    a = -jnp.exp(a_log.astype(jnp.float32)).reshape(g, r)
    a_dt = (dt * a).reshape(b, nc, CHUNK, g, r).transpose(0, 3, 4, 1, 2)
    xdt = (xs.astype(jnp.float32) * dt[..., None]).reshape(b, nc, CHUNK, g, r, p)
    bc = bs.astype(jnp.float32).reshape(b, nc, CHUNK, g, D_STATE)
    cc = cs.astype(jnp.float32).reshape(b, nc, CHUNK, g, D_STATE)
    a_cum = jnp.cumsum(a_dt, axis=-1)
    seg = a_cum[..., :, None] - a_cum[..., None, :]
    mask = jnp.tril(jnp.ones((CHUNK, CHUNK), dtype=bool))
    l_mat = jnp.exp(jnp.where(mask, seg, -jnp.inf))
    y_diag = jnp.einsum("bclgn,bcsgn,bgrcls,bcsgrp->bclgrp", cc, bc, l_mat, xdt)
    decay_states = jnp.exp(a_cum[..., -1:] - a_cum)
    states = jnp.einsum("bclgn,bgrcl,bclgrp->bcgrpn", bc, decay_states, xdt)
    chunk_decay = jnp.exp(a_cum[..., -1])

    def carry_state(h, inp):
        s_c, d_c = inp
        return h * d_c[..., None, None] + s_c, h

    h0 = jnp.zeros((b, g, r, p, D_STATE), jnp.float32)
    _, states_in = lax.scan(carry_state, h0, (jnp.moveaxis(states, 1, 0), jnp.moveaxis(chunk_decay, -1, 0)))
    states_in = jnp.moveaxis(states_in, 0, 1)
    y_off = jnp.einsum("bclgn,bcgrpn,bgrcl->bclgrp", cc, states_in, jnp.exp(a_cum))
    return (y_diag + y_off).reshape(b, s, g, r, p)


def ssd_mixer(z, xbc, dt_f, dt_b, conv_w, conv_b, a_log_fwd, a_log_bwd, dt_bias_fwd, dt_bias_bwd,
              d_skip, ssm_out_norm):
    b, s, _ = z.shape
    xbc = lax.conv_general_dilated(
        xbc, conv_w, window_strides=(1,), padding=((D_CONV // 2, D_CONV // 2),),
        dimension_numbers=("NWC", "WIO", "NWC"), feature_group_count=CONV_DIM)
    xbc = jax.nn.silu(xbc + conv_b)
    gn = SSM_GROUPS * D_STATE
    xs = xbc[..., :SSM_WIDTH].reshape(b, s, SSM_GROUPS, SSM_HEADS_PER_GROUP, SSM_HEAD_DIM)
    bs = xbc[..., SSM_WIDTH:SSM_WIDTH + gn].reshape(b, s, SSM_GROUPS, D_STATE)
    cs = xbc[..., SSM_WIDTH + gn:].reshape(b, s, SSM_GROUPS, D_STATE)
    y_fwd = ssd_scan(xs, dt_f, a_log_fwd, dt_bias_fwd, bs, cs)
    y_bwd = jnp.flip(ssd_scan(jnp.flip(xs, 1), jnp.flip(dt_b, 1), a_log_bwd, dt_bias_bwd,
                              jnp.flip(bs, 1), jnp.flip(cs, 1)), 1)
    d = d_skip.astype(jnp.float32).reshape(SSM_GROUPS, SSM_HEADS_PER_GROUP)[..., None]
    y = y_fwd + y_bwd + d * xs.astype(jnp.float32)
    y = y.reshape(b, s, SSM_WIDTH) * jax.nn.silu(z.astype(jnp.float32))
    y = rms_norm(y.reshape(b, s, SSM_GROUPS, SSM_WIDTH // SSM_GROUPS),
                 ssm_out_norm.reshape(SSM_GROUPS, SSM_WIDTH // SSM_GROUPS))
    return y.reshape(b, s, SSM_WIDTH).astype(z.dtype)


def peer_ffn(xn, w_query, sub_keys, expert_u, expert_v):
    b, s, d = xn.shape
    q = (xn @ w_query).reshape(b, s, PEER_HEADS, 2, PEER_QDIM // 2)
    sc = jnp.einsum("bshcd,hckd->bshck", q, sub_keys, preferred_element_type=jnp.float32)
    v1, i1 = lax.top_k(sc[..., 0, :], PEER_TOPK)
    v2, i2 = lax.top_k(sc[..., 1, :], PEER_TOPK)
    cand = (v1[..., :, None] + v2[..., None, :]).reshape(b, s, PEER_HEADS, PEER_TOPK * PEER_TOPK)
    top_s, top_c = lax.top_k(cand, PEER_TOPK)
    e1 = jnp.take_along_axis(i1, top_c // PEER_TOPK, axis=-1)
    e2 = jnp.take_along_axis(i2, top_c % PEER_TOPK, axis=-1)
    idx = (e1 * N_KEYS + e2).reshape(b * s, PEER_HEADS * PEER_TOPK)
    gates = jax.nn.softmax(top_s, axis=-1).reshape(b * s, PEER_HEADS * PEER_TOPK)
    n_blk = (b * s) // PEER_TOKEN_BLOCK
    xb = xn.reshape(n_blk, PEER_TOKEN_BLOCK, d)
    idx_b = idx.reshape(n_blk, PEER_TOKEN_BLOCK, PEER_HEADS * PEER_TOPK)
    g_b = gates.reshape(n_blk, PEER_TOKEN_BLOCK, PEER_HEADS * PEER_TOPK)

    def block(args):
        xt, it, gt = args
        u = expert_u[it]
        v = expert_v[it]
        act = jax.nn.gelu(jnp.einsum("td,tkd->tk", xt, u, preferred_element_type=jnp.float32))
        return jnp.einsum("tk,tkd->td", (gt * act).astype(v.dtype), v)

    out = lax.map(block, (xb, idx_b, g_b))
    return out.reshape(b, s, d)


def setup_inputs(seed: int = 0) -> dict:
    key = jax.random.key(seed)
    ks = jax.random.split(key, 26)
    L = DEPTH

    def normal(k, shape, scale):
        return jax.random.normal(k, shape, jnp.float32) * scale

    def gain(k, shape):
        return 1.0 + 0.01 * jax.random.normal(k, shape, jnp.float32)

    def dt_bias(k):
        dt = jnp.exp(jax.random.uniform(k, (L, SSM_HEADS), jnp.float32,
                                        minval=math.log(1e-3), maxval=math.log(1e-1)))
        return dt + jnp.log(-jnp.expm1(-dt))

    x = normal(ks[0], (BATCH, SEQ, D_MODEL), 1.0)
    positions = (jax.random.randint(ks[1], (BATCH, 1), 0, 4096, dtype=jnp.int32)
                 + jnp.arange(SEQ, dtype=jnp.int32)[None, :])
    return {
        "x": x,
        "positions": positions,
        "norm_mix": gain(ks[2], (L, D_MODEL)),
        "w_in": normal(ks[3], (L, D_MODEL, IN_WIDTH), D_MODEL ** -0.5),
        "q_a_norm": gain(ks[4], (L, Q_LORA_RANK)),
        "w_uq": normal(ks[5], (L, Q_LORA_RANK, MLA_HEADS * QK_HEAD_DIM), Q_LORA_RANK ** -0.5),
        "kv_a_norm": gain(ks[6], (L, KV_LORA_RANK)),
        "w_ukv": normal(ks[7], (L, KV_LORA_RANK, MLA_HEADS * (QK_NOPE_DIM + V_HEAD_DIM)), KV_LORA_RANK ** -0.5),
        "q_norm": gain(ks[8], (L, QK_HEAD_DIM)),
        "k_norm": gain(ks[9], (L, QK_HEAD_DIM)),
        "attn_out_norm": gain(ks[10], (L, MLA_HEADS, V_HEAD_DIM)),
        "conv_w": normal(ks[11], (L, D_CONV, 1, CONV_DIM), D_CONV ** -0.5),
        "conv_b": normal(ks[12], (L, CONV_DIM), 0.01),
        "a_log_fwd": jnp.log(jax.random.uniform(ks[13], (L, SSM_HEADS), jnp.float32, minval=1.0, maxval=16.0)),
        "a_log_bwd": jnp.log(jax.random.uniform(ks[14], (L, SSM_HEADS), jnp.float32, minval=1.0, maxval=16.0)),
        "dt_bias_fwd": dt_bias(ks[15]),
        "dt_bias_bwd": dt_bias(ks[16]),
        "d_skip": gain(ks[17], (L, SSM_HEADS)),
        "ssm_out_norm": gain(ks[18], (L, SSM_WIDTH)),
        "w_out": normal(ks[19], (L, MIX_WIDTH, D_MODEL), MIX_WIDTH ** -0.5),
        "norm_ffn": gain(ks[20], (L, D_MODEL)),
        "w_query": normal(ks[21], (L, D_MODEL, PEER_HEADS * PEER_QDIM), D_MODEL ** -0.5),
        "sub_keys": normal(ks[22], (L, PEER_HEADS, 2, N_KEYS, PEER_QDIM // 2), (PEER_QDIM // 2) ** -0.5),
        "expert_u": normal(ks[23], (L, N_EXPERTS, D_MODEL), D_MODEL ** -0.5),
        "expert_v": normal(ks[24], (L, N_EXPERTS, D_MODEL), PEER_TOPK ** -0.5),
    }


def reference(x, positions, norm_mix, w_in, q_a_norm, w_uq, kv_a_norm, w_ukv, q_norm, k_norm,
              attn_out_norm, conv_w, conv_b, a_log_fwd, a_log_bwd, dt_bias_fwd, dt_bias_bwd, d_skip,
              ssm_out_norm, w_out, norm_ffn, w_query, sub_keys, expert_u, expert_v):
    h = x
    for l in range(DEPTH):
        xn = rms_norm(h, norm_mix[l])
        proj = xn @ w_in[l]
        c_q, c_kv, k_rope, z, xbc, dt_f, dt_b = jnp.split(proj, IN_SPLITS, axis=-1)
        attn = mla_mixer(c_q, c_kv, k_rope, positions, q_a_norm[l], w_uq[l], kv_a_norm[l], w_ukv[l],
                         q_norm[l], k_norm[l], attn_out_norm[l])
        ssm = ssd_mixer(z, xbc, dt_f, dt_b, conv_w[l], conv_b[l], a_log_fwd[l], a_log_bwd[l],
                        dt_bias_fwd[l], dt_bias_bwd[l], d_skip[l], ssm_out_norm[l])
        h = h + jnp.concatenate([attn, ssm.astype(attn.dtype)], axis=-1) @ w_out[l]
        hn = rms_norm(h, norm_ffn[l])
        h = h + peer_ffn(hn, w_query[l], sub_keys[l], expert_u[l], expert_v[l]).astype(h.dtype)
    return h.astype(x.dtype)
```

```cpp
#include <hip/hip_runtime.h>
#include <hip/hip_cooperative_groups.h>
#include <cstdio>
#include <cstdint>
namespace cg = cooperative_groups;

typedef unsigned short bf16_t;
typedef __attribute__((ext_vector_type(8))) short bf16x8;
typedef __attribute__((ext_vector_type(4))) float f32x4;
typedef __attribute__((ext_vector_type(16))) float f32x16;
typedef __attribute__((ext_vector_type(4))) unsigned u32x4;
typedef __attribute__((ext_vector_type(2))) unsigned u32x2;

#ifndef ONE_LAUNCH
#define ONE_LAUNCH 1
#endif

constexpr int T_ = 8192, S_ = 2048, D_ = 4096, PJW = 7744;
constexpr int NPHASE = 11;
constexpr int FP8_EARLY = 1344;
constexpr int LDS_BYTES = 73728 + 256;
#ifndef GBM
#define GBM 256
#endif
#ifndef GNST
#define GNST 3
#endif

constexpr size_t SZ_WIN = (size_t)7808 * 4096 * 2, SZ_WUQ = (size_t)3072 * 1024 * 2, SZ_WUKV = (size_t)4096 * 512 * 2,
                 SZ_WOUT = (size_t)4096 * 4096 * 2, SZ_WQ = (size_t)2048 * 4096 * 2, SZ_SK = (size_t)16 * 128 * 128 * 2;
constexpr size_t OFF_WIN = 0, OFF_WUQ = OFF_WIN + SZ_WIN, OFF_WUKV = OFF_WUQ + SZ_WUQ, OFF_WOUT = OFF_WUKV + SZ_WUKV,
                 OFF_WQ = OFF_WOUT + SZ_WOUT, OFF_SK = OFF_WQ + SZ_WQ;
constexpr size_t OFF_A = OFF_SK + SZ_SK;
constexpr size_t OFF_B = OFF_A + (size_t)T_ * 4096 * 2;
constexpr size_t OFF_DTRAW = OFF_B + (size_t)T_ * PJW * 2;
constexpr size_t OFF_DT = OFF_DTRAW + (size_t)T_ * 64 * 4;
constexpr size_t OFF_ACUM = OFF_DT + (size_t)2 * T_ * 32 * 4;
constexpr size_t OFF_CQN = OFF_ACUM + (size_t)2 * T_ * 32 * 4;
constexpr size_t OFF_CKVN = OFF_CQN + (size_t)T_ * 1024 * 2;
constexpr size_t OFF_QRAW = OFF_CKVN + (size_t)T_ * 512 * 2;
constexpr size_t OFF_KVRAW = OFF_QRAW + (size_t)T_ * 3072 * 2;
constexpr size_t OFF_ST = OFF_KVRAW + (size_t)T_ * 4096 * 2;
constexpr size_t OFF_Q = OFF_ST + (size_t)2 * 4 * 16 * 32 * 64 * 128 * 2;
constexpr size_t OFF_K = OFF_Q + (size_t)4 * 16 * 2048 * 192 * 2;
constexpr size_t OFF_VT = OFF_K + (size_t)4 * 16 * 2048 * 192 * 2;
constexpr size_t OFF_EU8 = OFF_VT + (size_t)4 * 16 * 128 * 2048 * 2;
constexpr size_t OFF_EV8 = OFF_EU8 + (size_t)16384 * 4096;
constexpr size_t OFF_ESC = OFF_EV8 + (size_t)16384 * 4096;
constexpr size_t OFF_BAR = OFF_ESC + (size_t)2 * 16384 * 4;
constexpr size_t BAR_BYTES = 3456 * 4;
constexpr size_t OFF_END = OFF_BAR + 16384;
constexpr size_t OFF_QP = OFF_B;
constexpr size_t OFF_SC = OFF_B + (size_t)T_ * 2048 * 2;
constexpr size_t OFF_MIX = OFF_QRAW;

struct Params {
  const float* x; const int* pos; const float* norm_mix; const float* w_in; const float* q_a_norm; const float* w_uq;
  const float* kv_a_norm; const float* w_ukv; const float* q_norm; const float* k_norm; const float* attn_out_norm;
  const float* conv_w; const float* conv_b; const float* a_log_f; const float* a_log_b; const float* dt_bias_f; const float* dt_bias_b;
  const float* d_skip; const float* ssm_out_norm; const float* w_out; const float* norm_ffn; const float* w_query; const float* sub_keys;
  const float* expert_u; const float* expert_v;
  float* out; unsigned char* ws;
  long long ph_lo, ph_hi;
};

typedef __bf16 hwbf16x2 __attribute__((ext_vector_type(2)));
typedef float hwf32x2 __attribute__((ext_vector_type(2)));
__device__ __forceinline__ unsigned short f2bf(float f) { return __builtin_bit_cast(unsigned short, (__bf16)f); }
__device__ __forceinline__ float bf2f(unsigned short h) { return __uint_as_float(((unsigned)h) << 16); }
__device__ __forceinline__ unsigned pack2(float a, float b) { hwf32x2 f = {a, b}; return __builtin_bit_cast(unsigned, __builtin_convertvector(f, hwbf16x2)); }
__device__ __forceinline__ float bflo(unsigned u) { return __uint_as_float(u << 16); }
__device__ __forceinline__ float bfhi(unsigned u) { return __uint_as_float(u & 0xffff0000u); }
union U4B8 { uint4 u; bf16x8 v; };
__device__ __forceinline__ bf16x8 pack8(float a0, float a1, float a2, float a3, float a4, float a5, float a6, float a7) {
  U4B8 x; x.u = make_uint4(pack2(a0, a1), pack2(a2, a3), pack2(a4, a5), pack2(a6, a7)); return x.v;
}
__device__ __forceinline__ bf16x8 mk8(uint2 lo, uint2 hi) { U4B8 x; x.u = make_uint4(lo.x, lo.y, hi.x, hi.y); return x.v; }
__device__ __forceinline__ float wave_sum(float v) {
#pragma unroll
  for (int o = 32; o; o >>= 1) v += __shfl_xor(v, o);
  return v;
}
__device__ __forceinline__ void wave_argmax(float& v, int& i) {
#pragma unroll
  for (int o = 32; o; o >>= 1) {
    float ov = __shfl_xor(v, o); int oi = __shfl_xor(i, o);
    if (ov > v || (ov == v && oi < i)) { v = ov; i = oi; }
  }
}
__device__ __forceinline__ int opaque_tid() { int t = threadIdx.x; asm volatile("" : "+v"(t)); return t; }
__device__ __forceinline__ unsigned char* opaque_ptr(unsigned char* q) { asm volatile("" : "+s"(q)); return q; }
typedef float f32x2_t __attribute__((ext_vector_type(2)));
template <int CTRL> __device__ __forceinline__ float dppx(float v) { return __int_as_float(__builtin_amdgcn_update_dpp(0, __float_as_int(v), CTRL, 0xF, 0xF, true)); }
__device__ __forceinline__ float wave_sum_fast(float v) {
  v += dppx<0xB1>(v); v += dppx<0x4E>(v); v += dppx<0x141>(v); v += dppx<0x140>(v);
  const int iv = __float_as_int(v);
  return __int_as_float(__builtin_amdgcn_readlane(iv, 0)) + __int_as_float(__builtin_amdgcn_readlane(iv, 16)) +
         __int_as_float(__builtin_amdgcn_readlane(iv, 32)) + __int_as_float(__builtin_amdgcn_readlane(iv, 48));
}
__device__ __forceinline__ unsigned fkey(float f) { unsigned u = __float_as_uint(f); return (u & 0x80000000u) ? ~u : (u | 0x80000000u); }
__device__ __forceinline__ void fp8_row(const float* __restrict__ src, unsigned char* __restrict__ dst, float* __restrict__ scale_out, int lane) {
  float4 v[16]; float amax = 0.f;
#pragma unroll
  for (int j = 0; j < 16; ++j) {
    float4 t = ((const float4*)src)[lane + 64 * j]; v[j] = t;
    amax = fmaxf(amax, fmaxf(fmaxf(fabsf(t.x), fabsf(t.y)), fmaxf(fabsf(t.z), fabsf(t.w))));
  }
#pragma unroll
  for (int o = 32; o; o >>= 1) amax = fmaxf(amax, __shfl_xor(amax, o));
  const float sc = amax > 0.f ? 256.f / amax : 1.f;
  if (lane == 0) *scale_out = amax > 0.f ? amax * (1.f / 256.f) : 1.f;
#pragma unroll
  for (int j = 0; j < 16; ++j) {
    const float4 t = v[j];
    int wd = __builtin_amdgcn_cvt_pk_fp8_f32(t.x * sc, t.y * sc, 0, false);
    wd = __builtin_amdgcn_cvt_pk_fp8_f32(t.z * sc, t.w * sc, wd, true);
    ((unsigned*)dst)[lane + 64 * j] = (unsigned)wd;
  }
}
#define MFMA16(a, b, c) __builtin_amdgcn_mfma_f32_16x16x32_bf16(a, b, c, 0, 0, 0)
#define MFMA32(a, b, c) __builtin_amdgcn_mfma_f32_32x32x16_bf16(a, b, c, 0, 0, 0)

__device__ __forceinline__ void transpose_tile(const float* __restrict__ W, int K, int N, bf16_t* __restrict__ Wt, int tile, float* sm) {
  const int ntn = N >> 7; const int tk = tile / ntn, tn = tile - tk * ntn; const int k0 = tk << 6, n0 = tn << 7; const int tid = opaque_tid();
  float4 v[8];
#pragma unroll
  for (int i = 0; i < 8; ++i) v[i] = *(const float4*)(W + (size_t)(k0 + (tid >> 5) + 8 * i) * N + n0 + (tid & 31) * 4);
#pragma unroll
  for (int i = 0; i < 8; ++i) { float* d = sm + ((tid >> 5) + 8 * i) * 129 + (tid & 31) * 4; d[0] = v[i].x; d[1] = v[i].y; d[2] = v[i].z; d[3] = v[i].w; }
  __syncthreads();
#pragma unroll
  for (int i = 0; i < 4; ++i) {
    const int n = (tid >> 3) + 32 * i, kc = tid & 7; const float* s = sm + (kc * 8) * 129 + n;
    uint4 o; o.x = pack2(s[0], s[129]); o.y = pack2(s[258], s[387]); o.z = pack2(s[516], s[645]); o.w = pack2(s[774], s[903]);
    *(uint4*)(Wt + (size_t)(n0 + n) * K + k0 + kc * 8) = o;
  }
  __syncthreads();
}

template <int N>
__device__ __forceinline__ void rms_row_f32(const float* __restrict__ in, const float* __restrict__ gain, bf16_t* __restrict__ out, int lane) {
  constexpr int C = N / 256; float4 v[C]; float ss = 0.f;
#pragma unroll
  for (int i = 0; i < C; ++i) { v[i] = ((const float4*)in)[lane + 64 * i]; ss += v[i].x * v[i].x + v[i].y * v[i].y + v[i].z * v[i].z + v[i].w * v[i].w; }
  ss = wave_sum(ss); const float r = rsqrtf(ss * (1.f / N) + 1e-6f);
#pragma unroll
  for (int i = 0; i < C; ++i) {
    float4 g = ((const float4*)gain)[lane + 64 * i]; uint2 o;
    o.x = pack2(v[i].x * r * g.x, v[i].y * r * g.y); o.y = pack2(v[i].z * r * g.z, v[i].w * r * g.w);
    ((uint2*)out)[lane + 64 * i] = o;
  }
}
template <int N>
__device__ __forceinline__ void rms_row_bf16(const bf16_t* __restrict__ in, const float* __restrict__ gain, bf16_t* __restrict__ out, int lane) {
  constexpr int C = N / 256; uint2 v[C]; float ss = 0.f;
#pragma unroll
  for (int i = 0; i < C; ++i) { v[i] = ((const uint2*)in)[lane + 64 * i]; float a = bflo(v[i].x), b = bfhi(v[i].x), c = bflo(v[i].y), d = bfhi(v[i].y); ss += a * a + b * b + c * c + d * d; }
  ss = wave_sum(ss); const float r = rsqrtf(ss * (1.f / N) + 1e-6f);
#pragma unroll
  for (int i = 0; i < C; ++i) {
    float4 g = ((const float4*)gain)[lane + 64 * i]; uint2 o;
    o.x = pack2(bflo(v[i].x) * r * g.x, bfhi(v[i].x) * r * g.y); o.y = pack2(bflo(v[i].y) * r * g.z, bfhi(v[i].y) * r * g.w);
    ((uint2*)out)[lane + 64 * i] = o;
  }
}

#define GEMM_WAITV(n) asm volatile("s_waitcnt vmcnt(" #n ")" ::: "memory")
#define GEMM_RAWBAR() do { asm volatile("s_waitcnt lgkmcnt(0)" ::: "memory"); __builtin_amdgcn_s_barrier(); } while (0)
template <int BM, int NST, class Epi>
__device__ __forceinline__ void gemm_tile(const bf16_t* __restrict__ A, int lda, const bf16_t* __restrict__ B, int ldb, int K, int m0, int n0,
                                          unsigned char* smem, const Epi& epi) {
  constexpr int MI = BM / 32, NA = BM / 64, NV = NA + 2, D = NST - 1, STAGE_EL = (BM + 128) * 32;
  static_assert(NST == 3 || NST == 4, "ring depth");
  bf16_t* ring = (bf16_t*)smem;
  const int tid = opaque_tid(), lane = tid & 63, w = __builtin_amdgcn_readfirstlane(tid >> 6), wm = w >> 1, wn = w & 1;
  f32x4 acc[MI][4];
#pragma unroll
  for (int i = 0; i < MI; ++i)
#pragma unroll
    for (int j = 0; j < 4; ++j) acc[i][j] = (f32x4){0.f, 0.f, 0.f, 0.f};
  const int srow = tid >> 2, slc = (tid & 3) ^ ((tid >> 4) & 3);
  const bf16_t* Ag = A + (size_t)(m0 + srow) * lda + slc * 8;
  const bf16_t* Bg = B + (size_t)(n0 + srow) * ldb + slc * 8;
  const int nk = K >> 5;
#define GEMM_ISSUE(st, k0)                                                                                                     \
  do { bf16_t* sa_ = ring + (st) * STAGE_EL; bf16_t* sb_ = sa_ + BM * 32;                                                      \
    _Pragma("unroll") for (int i = 0; i < NA; ++i)                                                                             \
      __builtin_amdgcn_global_load_lds((const unsigned*)(Ag + (size_t)(64 * i) * lda + (k0)), (unsigned*)(sa_ + (i * 256 + w * 64) * 8), 16, 0, 0); \
    _Pragma("unroll") for (int i = 0; i < 2; ++i)                                                                              \
      __builtin_amdgcn_global_load_lds((const unsigned*)(Bg + (size_t)(64 * i) * ldb + (k0)), (unsigned*)(sb_ + (i * 256 + w * 64) * 8), 16, 0, 0); \
  } while (0)
  GEMM_ISSUE(0, 0);
  if (nk > 1) GEMM_ISSUE(1, 32);
  if (D >= 3 && nk > 2) GEMM_ISSUE(2, 64);
  const int fr = lane & 15, fq = lane >> 4;
  const int foff = fr * 32 + ((fq ^ ((fr >> 2) & 3)) * 8);
  int st = 0, stn = D % NST;
  for (int kt = 0; kt < nk; ++kt) {
    const int rem = min(D - 1, nk - 1 - kt);
    if (rem >= 2) { if (NV == 4) GEMM_WAITV(8); else GEMM_WAITV(12); }
    else if (rem == 1) { if (NV == 4) GEMM_WAITV(4); else GEMM_WAITV(6); }
    else GEMM_WAITV(0);
    GEMM_RAWBAR();
    const bf16_t* a_ = ring + st * STAGE_EL + (wm * (BM / 2)) * 32 + foff;
    const bf16_t* b_ = ring + st * STAGE_EL + BM * 32 + (wn * 64) * 32 + foff;
    bf16x8 af[MI], bfr[4];
#pragma unroll
    for (int j = 0; j < 4; ++j) bfr[j] = *(const bf16x8*)(b_ + j * 16 * 32);
#pragma unroll
    for (int i = 0; i < MI; ++i) af[i] = *(const bf16x8*)(a_ + i * 16 * 32);
    __builtin_amdgcn_sched_barrier(0);
    if (kt + D < nk) {
      bf16_t* sa_ = ring + stn * STAGE_EL; bf16_t* sb_ = sa_ + BM * 32; const int k0n = (kt + D) << 5;
#pragma unroll
      for (int i = 0; i < MI; ++i) {
#pragma unroll
        for (int j = 0; j < 4; ++j) acc[i][j] = MFMA16(af[i], bfr[j], acc[i][j]);
        if (i < NA) __builtin_amdgcn_global_load_lds((const unsigned*)(Ag + (size_t)(64 * i) * lda + k0n), (unsigned*)(sa_ + (i * 256 + w * 64) * 8), 16, 0, 0);
        else if (i < NV) __builtin_amdgcn_global_load_lds((const unsigned*)(Bg + (size_t)(64 * (i - NA)) * ldb + k0n), (unsigned*)(sb_ + ((i - NA) * 256 + w * 64) * 8), 16, 0, 0);
        __builtin_amdgcn_sched_barrier(0);
      }
    } else {
#pragma unroll
      for (int i = 0; i < MI; ++i)
#pragma unroll
        for (int j = 0; j < 4; ++j) acc[i][j] = MFMA16(af[i], bfr[j], acc[i][j]);
    }
    st = (st + 1 == NST) ? 0 : st + 1; stn = (stn + 1 == NST) ? 0 : stn + 1;
  }
  GEMM_RAWBAR();
#undef GEMM_ISSUE
  {
    float* stg = (float*)(smem + w * 18432);
    constexpr int SSTR = 68;
#pragma unroll
    for (int h = 0; h < MI / 4; ++h) {
#pragma unroll
      for (int i4 = 0; i4 < 4; ++i4)
#pragma unroll
        for (int j = 0; j < 4; ++j)
#pragma unroll
          for (int r = 0; r < 4; ++r) stg[(i4 * 16 + (lane >> 4) * 4 + r) * SSTR + j * 16 + (lane & 15)] = acc[h * 4 + i4][j][r];
      asm volatile("s_waitcnt lgkmcnt(0)" ::: "memory");
#pragma unroll
      for (int it = 0; it < 16; ++it) {
        const int rr = it * 4 + (lane >> 4);
        const float4 v = *(const float4*)(stg + rr * SSTR + (lane & 15) * 4);
        epi.store4(m0 + wm * (BM / 2) + h * 64 + rr, n0 + wn * 64 + (lane & 15) * 4, v);
      }
      asm volatile("s_waitcnt lgkmcnt(0)" ::: "memory");
    }
  }
  asm volatile("s_waitcnt vmcnt(0)" ::: "memory");
  GEMM_RAWBAR();
}

template <class F>
__device__ __forceinline__ void for_gemm_tiles(int MT, int NT, F f) {
  const int xcd = blockIdx.x & 7, local = blockIdx.x >> 3, nloc = gridDim.x >> 3;
  const int SM = (MT + 7) >> 3, SN = (NT + 7) >> 3, nsup = SM * SN, per_xcd = (nsup + 7) >> 3;
  for (int idx = local; idx < per_xcd * 64; idx += nloc) {
    const int st = (idx >> 6) * 8 + xcd; if (st >= nsup) continue;
    const int within = idx & 63; const int mt = (st / SN) * 8 + (within >> 3), nt = (st % SN) * 8 + (within & 7);
    if (mt < MT && nt < NT) f(mt, nt);
  }
}

struct EpiProj { bf16_t* proj; float* dtraw;
  __device__ __forceinline__ void store4(int r, int c, float4 v) const {
    if (c < PJW) { uint2 o; o.x = pack2(v.x, v.y); o.y = pack2(v.z, v.w); *(uint2*)(proj + (size_t)r * PJW + c) = o; }
    else *(float4*)(dtraw + r * 64 + c - PJW) = v; } };
struct EpiBf16 { bf16_t* o; int ld;
  __device__ __forceinline__ void store4(int r, int c, float4 v) const { uint2 t; t.x = pack2(v.x, v.y); t.y = pack2(v.z, v.w); *(uint2*)(o + (size_t)r * ld + c) = t; } };
struct EpiOut { const float* x; float* o;
  __device__ __forceinline__ void store4(int r, int c, float4 v) const { size_t i = (size_t)r * D_ + c; float4 xv = *(const float4*)(x + i); *(float4*)(o + i) = make_float4(xv.x + v.x, xv.y + v.y, xv.z + v.z, xv.w + v.w); } };
struct EpiF32 { float* o; int ld;
  __device__ __forceinline__ void store4(int r, int c, float4 v) const { *(float4*)(o + (size_t)r * ld + c) = v; } };

__device__ __forceinline__ void late_transposes(const Params& p, int first, int stride, unsigned char* smem) {
  unsigned char* ws = p.ws;
  for (int t = first; t < 3072; t += stride) {
    if (t < 2048) transpose_tile(p.w_out, 4096, 4096, (bf16_t*)(ws + OFF_WOUT), t, (float*)smem);
    else transpose_tile(p.w_query, 4096, 2048, (bf16_t*)(ws + OFF_WQ), t - 2048, (float*)smem);
  }
}

__device__ __forceinline__ void fp8_convert_tiles(const Params& p, int first, int stride) {
  unsigned char* ws = p.ws; const float* eu = p.expert_u; const float* ev = p.expert_v;
  for (int t = first; t < 8192; t += stride) {
    const int tid2 = opaque_tid(); const int row = t * 4 + (tid2 >> 6); const int tb = row >> 14, r = row & 16383;
    fp8_row((tb ? ev : eu) + (size_t)r * 4096, ws + (tb ? OFF_EV8 : OFF_EU8) + (size_t)r * 4096, (float*)(ws + OFF_ESC) + row, tid2 & 63);
  }
}

__device__ __forceinline__ void phase0(const Params& p, unsigned char* smem) {
  unsigned char* ws = p.ws;
  const int n0 = 3904, n1 = n0 + 384, n2 = n1 + 256, n3 = n2 + 2048, n4 = n3 + 1024, n5 = n4 + 64, n6 = n5 + 2048;
  if (gridDim.x != 512) fp8_convert_tiles(p, blockIdx.x, gridDim.x);
  const int tid = opaque_tid(), lane = tid & 63, w = tid >> 6;
  for (int t = blockIdx.x; t < n6; t += gridDim.x) {
    if (t < n0) transpose_tile(p.w_in, 4096, 7808, (bf16_t*)(ws + OFF_WIN), t, (float*)smem);
    else if (t < n1) transpose_tile(p.w_uq, 1024, 3072, (bf16_t*)(ws + OFF_WUQ), t - n0, (float*)smem);
    else if (t < n2) transpose_tile(p.w_ukv, 512, 4096, (bf16_t*)(ws + OFF_WUKV), t - n1, (float*)smem);
    else if (t < n4) { if (gridDim.x != 512) late_transposes(p, t - n2, 1 << 30, smem); }

    else if (t < n5) {
      const int base = (t - n4) * 4096; bf16_t* sk = (bf16_t*)(ws + OFF_SK);
#pragma unroll
      for (int i = 0; i < 4; ++i) { int e = base + (tid + 256 * i) * 4; float4 v = *(const float4*)(p.sub_keys + e); uint2 o; o.x = pack2(v.x, v.y); o.y = pack2(v.z, v.w); *(uint2*)(sk + e) = o; }
    } else {
      const int row = (t - n5) * 4 + w;
      rms_row_f32<4096>(p.x + (size_t)row * D_, p.norm_mix, (bf16_t*)(ws + OFF_A) + (size_t)row * D_, lane);
    }
  }
}

__device__ __forceinline__ void phase1(const Params& p, unsigned char* smem) {
  unsigned char* ws = p.ws;
  EpiProj epi{(bf16_t*)(ws + OFF_B), (float*)(ws + OFF_DTRAW)};
  const bf16_t* A = (const bf16_t*)(ws + OFF_A); const bf16_t* B = (const bf16_t*)(ws + OFF_WIN);
  for_gemm_tiles(T_ / GBM, 61, [&](int mt, int nt) { gemm_tile<GBM, GNST>(A, 4096, B, 4096, 4096, mt * GBM, nt * 128, smem, epi); });
  if (gridDim.x == 512 && (blockIdx.x & 7) == 7 && ((blockIdx.x >> 3) & 7) >= 5) {
    const int local = blockIdx.x >> 3; const int bi = (local >> 3) * 3 + ((local & 7) - 5);
    for (int t = bi; t < FP8_EARLY; t += 24) fp8_convert_tiles(p, t, 1 << 30);
  }
}

__device__ __forceinline__ void phase2(const Params& p, unsigned char* smem) {
  unsigned char* ws = p.ws;
  const int tid = opaque_tid(), lane = tid & 63, w = tid >> 6;
  const bf16_t* proj = (const bf16_t*)(ws + OFF_B);
  for (int t = blockIdx.x; t < 16; t += gridDim.x) {
    const int gid = t * 256 + tid; const int h = gid & 31, c = (gid >> 5) & 15, b = (gid >> 9) & 3, dir = gid >> 11;
    const float alf = p.a_log_f[h], alb = p.a_log_b[h], dbf = p.dt_bias_f[h], dbb = p.dt_bias_b[h];
    const float a = -expf(dir ? alb : alf); const float bias = dir ? dbb : dbf;
    const float* dtraw = (const float*)(ws + OFF_DTRAW) + dir * 32 + h; float* DT = (float*)(ws + OFF_DT) + (size_t)dir * T_ * 32 + h; float* AC = (float*)(ws + OFF_ACUM) + (size_t)dir * T_ * 32 + h;
    const int tbase = b * S_ + c * 128; const int l0 = dir ? 127 : 0, ls = dir ? -1 : 1;
    float cum = 0.f;
#pragma unroll 1
    for (int i0 = 0; i0 < 128; i0 += 16) {
      float raw[16];
#pragma unroll
      for (int j = 0; j < 16; ++j) raw[j] = dtraw[(tbase + l0 + ls * (i0 + j)) * 64];
#pragma unroll
      for (int j = 0; j < 16; ++j) {
        const int tt = tbase + l0 + ls * (i0 + j);
        const float r = raw[j] + bias; const float dt = fmaxf(r, 0.f) + log1pf(expf(-fabsf(r)));
        cum += dt * a; DT[tt * 32] = dt; AC[tt * 32] = cum;
      }
    }
  }
  for (int t = blockIdx.x; t < T_ / 4; t += gridDim.x) {
    const int row = t * 4 + w;
    rms_row_bf16<1024>(proj + (size_t)row * PJW, p.q_a_norm, (bf16_t*)(ws + OFF_CQN) + (size_t)row * 1024, lane);
    rms_row_bf16<512>(proj + (size_t)row * PJW + 1024, p.kv_a_norm, (bf16_t*)(ws + OFF_CKVN) + (size_t)row * 512, lane);
  }
  bf16_t* xc = (bf16_t*)(ws + OFF_A);
  for (int t = blockIdx.x; t < T_ / 4 * 2; t += gridDim.x) {
    const int idx = t * 256 + tid; const int tg = idx >> 9, c = (idx & 511) * 8; const int t0 = tg * 4; const int s0 = t0 & (S_ - 1);
    u32x4 rows[8];
#pragma unroll
    for (int j = 0; j < 8; ++j) {
      const int ss = s0 + j - 2;
      rows[j] = (ss >= 0 && ss < S_) ? *(const u32x4*)(proj + (size_t)(t0 + j - 2) * PJW + 3648 + c) : (u32x4){0u, 0u, 0u, 0u};
    }
    float wgt[5][8], bia[8];
#pragma unroll
    for (int wv = 0; wv < 5; ++wv) {
      const float4 w0 = *(const float4*)(p.conv_w + wv * 4096 + c), w1 = *(const float4*)(p.conv_w + wv * 4096 + c + 4);
      wgt[wv][0] = w0.x; wgt[wv][1] = w0.y; wgt[wv][2] = w0.z; wgt[wv][3] = w0.w; wgt[wv][4] = w1.x; wgt[wv][5] = w1.y; wgt[wv][6] = w1.z; wgt[wv][7] = w1.w;
    }
    { const float4 b0 = *(const float4*)(p.conv_b + c), b1 = *(const float4*)(p.conv_b + c + 4); bia[0] = b0.x; bia[1] = b0.y; bia[2] = b0.z; bia[3] = b0.w; bia[4] = b1.x; bia[5] = b1.y; bia[6] = b1.z; bia[7] = b1.w; }
#pragma unroll
    for (int o = 0; o < 4; ++o) {
      float acc[8];
#pragma unroll
      for (int e = 0; e < 8; ++e) acc[e] = bia[e];
#pragma unroll
      for (int wv = 0; wv < 5; ++wv) {
        const u32x4 v = rows[o + wv];
#pragma unroll
        for (int q = 0; q < 4; ++q) { acc[2 * q] += bflo(v[q]) * wgt[wv][2 * q]; acc[2 * q + 1] += bfhi(v[q]) * wgt[wv][2 * q + 1]; }
      }
#pragma unroll
      for (int e = 0; e < 8; ++e) acc[e] = acc[e] / (1.f + __expf(-acc[e]));
      u32x4 ov; ov[0] = pack2(acc[0], acc[1]); ov[1] = pack2(acc[2], acc[3]); ov[2] = pack2(acc[4], acc[5]); ov[3] = pack2(acc[6], acc[7]);
      *(u32x4*)(xc + (size_t)(t0 + o) * 4096 + c) = ov;
    }
  }
}

__device__ __forceinline__ void ssd_states_tile(const Params& p, int tile, unsigned char* smem) {
  unsigned char* ws = p.ws;
  const int g = tile & 7, c = (tile >> 3) & 15, b = tile >> 7; const int t0 = b * S_ + c * 128;
  const int tid = opaque_tid(), lane = tid & 63, w = tid >> 6;
  bf16_t* sBT = (bf16_t*)smem;
  bf16_t* sXT = sBT + 128 * 136;
  const bf16_t* xc = (const bf16_t*)(ws + OFF_A);
#pragma unroll
  for (int i = 0; i < 4; ++i) {
    const int item = tid + 256 * i; const int lp = item >> 4, nc = item & 15;
    uint4 v0 = *(const uint4*)(xc + (size_t)(t0 + 2 * lp) * 4096 + 2048 + g * 128 + nc * 8);
    uint4 v1 = *(const uint4*)(xc + (size_t)(t0 + 2 * lp + 1) * 4096 + 2048 + g * 128 + nc * 8);
    unsigned a0[4] = {v0.x, v0.y, v0.z, v0.w}, a1[4] = {v1.x, v1.y, v1.z, v1.w};
#pragma unroll
    for (int j = 0; j < 4; ++j) {
      *(unsigned*)(sBT + (nc * 8 + 2 * j) * 136 + 2 * lp) = (a0[j] & 0xffffu) | (a1[j] << 16);
      *(unsigned*)(sBT + (nc * 8 + 2 * j + 1) * 136 + 2 * lp) = (a0[j] >> 16) | (a1[j] & 0xffff0000u);
    }
  }
#pragma unroll 1
  for (int dr = 0; dr < 8; ++dr) {
    const int dir = dr >> 2, r = dr & 3, hd = g * 4 + r;
    const float* DT = (const float*)(ws + OFF_DT) + (size_t)dir * T_ * 32; const float* AC = (const float*)(ws + OFF_ACUM) + (size_t)dir * T_ * 32;
    const float aend = AC[(t0 + (dir ? 0 : 127)) * 32 + hd];
#pragma unroll
    for (int i = 0; i < 2; ++i) {
      const int item = tid + 256 * i; const int lp = item >> 3, pc = item & 7;
      const int l0 = 2 * lp, l1 = 2 * lp + 1;
      const float w0 = DT[(t0 + l0) * 32 + hd] * expf(aend - AC[(t0 + l0) * 32 + hd]);
      const float w1 = DT[(t0 + l1) * 32 + hd] * expf(aend - AC[(t0 + l1) * 32 + hd]);
      uint4 v0 = *(const uint4*)(xc + (size_t)(t0 + l0) * 4096 + hd * 64 + pc * 8);
      uint4 v1 = *(const uint4*)(xc + (size_t)(t0 + l1) * 4096 + hd * 64 + pc * 8);
      unsigned a0[4] = {v0.x, v0.y, v0.z, v0.w}, a1[4] = {v1.x, v1.y, v1.z, v1.w};
#pragma unroll
      for (int j = 0; j < 4; ++j) {
        *(unsigned*)(sXT + (pc * 8 + 2 * j) * 136 + l0) = pack2(bflo(a0[j]) * w0, bflo(a1[j]) * w1);
        *(unsigned*)(sXT + (pc * 8 + 2 * j + 1) * 136 + l0) = pack2(bfhi(a0[j]) * w0, bfhi(a1[j]) * w1);
      }
    }
    __syncthreads();
    f32x4 acc[8];
#pragma unroll
    for (int j = 0; j < 8; ++j) acc[j] = (f32x4){0.f, 0.f, 0.f, 0.f};
#pragma unroll
    for (int ks = 0; ks < 4; ++ks) {
      bf16x8 af = *(const bf16x8*)(sXT + (16 * w + (lane & 15)) * 136 + ks * 32 + (lane >> 4) * 8);
#pragma unroll
      for (int j = 0; j < 8; ++j) {
        bf16x8 bfr = *(const bf16x8*)(sBT + (j * 16 + (lane & 15)) * 136 + ks * 32 + (lane >> 4) * 8);
        acc[j] = MFMA16(af, bfr, acc[j]);
      }
    }
    bf16_t* st = (bf16_t*)(ws + OFF_ST) + ((((size_t)(dir * 4 + b) * 16 + c) * 32 + hd) * 64) * 128;
    bf16_t* stg = sXT + 64 * 136 + w * (16 * 136);
#pragma unroll
    for (int j = 0; j < 8; ++j)
#pragma unroll
      for (int rr = 0; rr < 4; ++rr) stg[((lane >> 4) * 4 + rr) * 136 + j * 16 + (lane & 15)] = f2bf(acc[j][rr]);
    asm volatile("s_waitcnt lgkmcnt(0)" ::: "memory");
#pragma unroll
    for (int q = 0; q < 4; ++q) {
      const int cc = lane + 64 * q; const int row = cc >> 4, ch = cc & 15;
      *(u32x4*)(st + (16 * w + row) * 128 + ch * 8) = *(const u32x4*)(stg + row * 136 + ch * 8);
    }
    __syncthreads();
  }
}

__device__ __forceinline__ void phase3(const Params& p, unsigned char* smem) {
  unsigned char* ws = p.ws;
  { EpiBf16 epi{(bf16_t*)(ws + OFF_QRAW), 3072};
    const bf16_t* A = (const bf16_t*)(ws + OFF_CQN); const bf16_t* B = (const bf16_t*)(ws + OFF_WUQ);
    for_gemm_tiles(T_ / GBM, 24, [&](int mt, int nt) { gemm_tile<GBM, GNST>(A, 1024, B, 1024, 1024, mt * GBM, nt * 128, smem, epi); }); }
  { EpiBf16 epi{(bf16_t*)(ws + OFF_KVRAW), 4096};
    const bf16_t* A = (const bf16_t*)(ws + OFF_CKVN); const bf16_t* B = (const bf16_t*)(ws + OFF_WUKV);
    for_gemm_tiles(T_ / GBM, 32, [&](int mt, int nt) { gemm_tile<GBM, GNST>(A, 512, B, 512, 512, mt * GBM, nt * 128, smem, epi); }); }
  if (gridDim.x == 512 && (blockIdx.x & 7) >= 4) late_transposes(p, (blockIdx.x >> 3) * 4 + ((blockIdx.x & 7) - 4), 256, smem);
  for (int t = blockIdx.x; t < 512; t += gridDim.x) ssd_states_tile(p, t, smem);
}

__device__ __forceinline__ void phase4(const Params& p, unsigned char* smem) {
  unsigned char* ws = p.ws;
  const int tid = opaque_tid(), lane = tid & 63, w = tid >> 6;
  for (int t = blockIdx.x; t < 1024; t += gridDim.x) {
    const int gid = t * 256 + tid; const int nch = gid & 15, pp = (gid >> 4) & 63, h = (gid >> 10) & 31, b = (gid >> 15) & 3, dir = gid >> 17;
    const float* AC = (const float*)(ws + OFF_ACUM) + (size_t)dir * T_ * 32;
    bf16_t* base = (bf16_t*)(ws + OFF_ST) + ((((size_t)(dir * 4 + b) * 16) * 32 + h) * 64 + pp) * 128 + nch * 8;
    u32x4 sv[16]; float dec[16];
#pragma unroll
    for (int i = 0; i < 16; ++i) {
      const int c = dir ? 15 - i : i;
      sv[i] = *(const u32x4*)(base + (size_t)c * (32 * 64 * 128));
      dec[i] = AC[(b * S_ + c * 128 + (dir ? 0 : 127)) * 32 + h];
    }
    float hs[8];
#pragma unroll
    for (int j = 0; j < 8; ++j) hs[j] = 0.f;
#pragma unroll
    for (int i = 0; i < 16; ++i) {
      const int c = dir ? 15 - i : i;
      u32x4 o; o[0] = pack2(hs[0], hs[1]); o[1] = pack2(hs[2], hs[3]); o[2] = pack2(hs[4], hs[5]); o[3] = pack2(hs[6], hs[7]);
      *(u32x4*)(base + (size_t)c * (32 * 64 * 128)) = o;
      const float d = expf(dec[i]);
#pragma unroll
      for (int q = 0; q < 4; ++q) { hs[2 * q] = hs[2 * q] * d + bflo(sv[i][q]); hs[2 * q + 1] = hs[2 * q + 1] * d + bfhi(sv[i][q]); }
    }
  }
  const bf16_t* proj = (const bf16_t*)(ws + OFF_B);
  const bf16_t* qraw = (const bf16_t*)(ws + OFF_QRAW); const bf16_t* kvraw = (const bf16_t*)(ws + OFF_KVRAW);
  const float qscale = 0.07216878364870322f * 1.4426950408889634f;
  const float* const qn_ = p.q_norm; const float* const kn_ = p.k_norm; const int* const pos_ = p.pos;
  const float gq0 = qn_[lane], gq1 = qn_[lane + 64], gq2 = qn_[lane + 128], gk0 = kn_[lane], gk1 = kn_[lane + 64], gk2 = kn_[lane + 128];
  const float invf = exp2f(-(float)(lane & 31) * (13.287712379549449f / 32.f));
  for (int tt = blockIdx.x * 4 + w; tt < T_; tt += gridDim.x * 4) {
    const float posf = (float)pos_[tt];
    float sn, cs; sincosf(posf * invf, &sn, &cs);
    const int b = tt >> 11, sq = tt & (S_ - 1);
    const float kr = bf2f(proj[(size_t)tt * PJW + 1536 + lane]);
    float x0[4], x1[4], x2[4], n0[4], n1[4], n2[4];
#define QK_LOAD(HQ, X0, X1, X2) do { const int wh_ = (HQ) >> 2, hh_ = ((HQ) & 3) * 4;                                       \
      _Pragma("unroll") for (int j = 0; j < 4; ++j) {                                                                       \
        const bf16_t* sp = wh_ ? (kvraw + (size_t)tt * 4096 + (hh_ + j) * 256) : (qraw + (size_t)tt * 3072 + (hh_ + j) * 192); \
        X0[j] = bf2f(sp[lane]); X1[j] = bf2f(sp[lane + 64]); X2[j] = wh_ ? kr : bf2f(sp[lane + 128]); } } while (0)
#define QK_PROC(HQ, X0, X1, X2) do { const int which = (HQ) >> 2, h0 = ((HQ) & 3) * 4;                                      \
      const float g0 = which ? gk0 : gq0, g1 = which ? gk1 : gq1, g2 = which ? gk2 : gq2;                                  \
      const float scl = which ? 1.f : qscale;                                                                               \
      bf16_t* dbase = (bf16_t*)(ws + (which == 0 ? OFF_Q : OFF_K)) + ((size_t)(b * 16 + h0) * S_ + sq) * 192;              \
      _Pragma("unroll") for (int j = 0; j < 4; ++j) {                                                                       \
        const float ss = wave_sum_fast(X0[j] * X0[j] + X1[j] * X1[j] + X2[j] * X2[j]);                                      \
        const float r = rsqrtf(ss * (1.f / 192.f) + 1e-6f);                                                                 \
        const float y0 = X0[j] * r * g0, y1 = X1[j] * r * g1, y2 = X2[j] * r * g2;                                          \
        const float other = __shfl_xor(y2, 32);                                                                             \
        const float yr = (lane < 32) ? (y2 * cs - other * sn) : (other * sn + y2 * cs);                                     \
        bf16_t* dst = dbase + (size_t)j * S_ * 192;                                                                         \
        dst[lane] = f2bf(y0 * scl); dst[lane + 64] = f2bf(y1 * scl); dst[lane + 128] = f2bf(yr * scl); } } while (0)
    QK_LOAD(0, x0, x1, x2);
#pragma unroll 1
    for (int hq = 0; hq < 8; hq += 2) {
      QK_LOAD(hq + 1, n0, n1, n2);
      QK_PROC(hq, x0, x1, x2);
      if (hq + 2 < 8) QK_LOAD(hq + 2, x0, x1, x2);
      QK_PROC(hq + 1, n0, n1, n2);
    }
#undef QK_LOAD
#undef QK_PROC
  }
  bf16_t* sm = (bf16_t*)smem;
  for (int t = blockIdx.x; t < 2048; t += gridDim.x) {
    const int sb = t & 31, head = (t >> 5) & 15, b = t >> 9; const int tbase = b * S_ + sb * 64;
    __syncthreads();
#pragma unroll
    for (int i = 0; i < 4; ++i) {
      const int cidx = tid + 256 * i; const int srow = cidx >> 4, dc = cidx & 15;
      uint4 v = *(const uint4*)(kvraw + (size_t)(tbase + srow) * 4096 + head * 256 + 128 + dc * 8);
      unsigned a[4] = {v.x, v.y, v.z, v.w};
#pragma unroll
      for (int j = 0; j < 4; ++j) { sm[(dc * 8 + 2 * j) * 72 + srow] = (bf16_t)(a[j] & 0xffffu); sm[(dc * 8 + 2 * j + 1) * 72 + srow] = (bf16_t)(a[j] >> 16); }
    }
    __syncthreads();
    bf16_t* vt = (bf16_t*)(ws + OFF_VT) + (size_t)(b * 16 + head) * 128 * S_ + sb * 64;
#pragma unroll
    for (int i = 0; i < 4; ++i) {
      const int cidx = tid + 256 * i; const int d = cidx >> 3, sc8 = cidx & 7;
      *(uint4*)(vt + (size_t)d * S_ + sc8 * 8) = *(const uint4*)(sm + d * 72 + sc8 * 8);
    }
  }
}

__device__ __forceinline__ void attn_tile(const Params& p, int tile, unsigned char* smem) {
  unsigned char* ws = p.ws;
  const int qb = tile & 15, head = (tile >> 4) & 15, b = tile >> 8;
  const int tid = opaque_tid(), lane = tid & 63, w = tid >> 6, lr = lane & 31, lh = lane >> 5;
  bf16_t* sK = (bf16_t*)smem;
  bf16_t* sV = sK + 64 * 200;
  const bf16_t* Qp = (const bf16_t*)(ws + OFF_Q) + ((size_t)(b * 16 + head) * S_ + qb * 128 + w * 32) * 192;
  const bf16_t* Kp = (const bf16_t*)(ws + OFF_K) + (size_t)(b * 16 + head) * S_ * 192;
  const bf16_t* Vp = (const bf16_t*)(ws + OFF_VT) + (size_t)(b * 16 + head) * 128 * S_;
  bf16x8 qf[12];
#pragma unroll
  for (int ks = 0; ks < 12; ++ks) qf[ks] = *(const bf16x8*)(Qp + lr * 192 + ks * 16 + lh * 8);
  f32x16 o[4];
#pragma unroll
  for (int d = 0; d < 4; ++d)
#pragma unroll
    for (int r = 0; r < 16; ++r) o[d][r] = 0.f;
  float m = -INFINITY, lsum = 0.f;
  u32x4 rk[6], rv[4];
  int koff[6];
#pragma unroll
  for (int i = 0; i < 6; ++i) { const int cidx = tid + 256 * i; const int row = cidx / 24; koff[i] = row * 200 + (cidx - row * 24) * 8; }
  const int vrow_ = tid >> 3, vkc = (tid & 7) * 8;
  const int vpos = (vkc & ~15) + ((vkc & 8) ? 4 : 0);
#pragma unroll
  for (int i = 0; i < 6; ++i) rk[i] = *(const u32x4*)(Kp + (size_t)(tid + 256 * i) * 8);
#pragma unroll
  for (int i = 0; i < 4; ++i) rv[i] = *(const u32x4*)(Vp + (size_t)(vrow_ + 32 * i) * S_ + vkc);
#pragma unroll 1
  for (int kt = 0; kt < 32; ++kt) {
    __syncthreads();
#pragma unroll
    for (int i = 0; i < 6; ++i) *(u32x4*)(sK + koff[i]) = rk[i];
#pragma unroll
    for (int i = 0; i < 4; ++i) { bf16_t* d = sV + (vrow_ + 32 * i) * 72 + vpos; *(u32x2*)d = (u32x2){rv[i][0], rv[i][1]}; *(u32x2*)(d + 8) = (u32x2){rv[i][2], rv[i][3]}; }
    __syncthreads();
    if (kt + 1 < 32) {
      const int key0 = (kt + 1) * 64;
#pragma unroll
      for (int i = 0; i < 6; ++i) rk[i] = *(const u32x4*)(Kp + (size_t)key0 * 192 + (size_t)(tid + 256 * i) * 8);
#pragma unroll
      for (int i = 0; i < 4; ++i) rv[i] = *(const u32x4*)(Vp + (size_t)(vrow_ + 32 * i) * S_ + key0 + vkc);
    }
    f32x16 s0, s1;
#pragma unroll
    for (int r = 0; r < 16; ++r) { s0[r] = 0.f; s1[r] = 0.f; }
    const bf16_t* kb0 = sK + lr * 200 + lh * 8; const bf16_t* kb1 = kb0 + 32 * 200;
#pragma unroll
    for (int ks = 0; ks < 12; ++ks) { const bf16x8 kf = *(const bf16x8*)(kb0 + ks * 16); s0 = MFMA32(kf, qf[ks], s0); }
    {
      float mx = fmaxf(fmaxf(s0[0], s0[1]), fmaxf(s0[2], s0[3]));
#pragma unroll
      for (int r = 4; r < 16; ++r) mx = fmaxf(mx, s0[r]);
      mx = fmaxf(mx, __shfl_xor(mx, 32));
      const float mn = fmaxf(m, mx);
      if (__builtin_amdgcn_ballot_w64(mn > m) != 0) {
        const float alpha = __builtin_amdgcn_exp2f(m - mn); lsum *= alpha;
#pragma unroll
        for (int d = 0; d < 4; ++d)
#pragma unroll
          for (int r = 0; r < 16; ++r) o[d][r] *= alpha;
      }
      m = mn;
    }
#pragma unroll
    for (int ks = 0; ks < 12; ++ks) { const bf16x8 kf = *(const bf16x8*)(kb1 + ks * 16); s1 = MFMA32(kf, qf[ks], s1); }
    float psA = 0.f;
#pragma unroll
    for (int r = 0; r < 16; ++r) { const float e = __builtin_amdgcn_exp2f(s0[r] - m); s0[r] = e; psA += e; }
    {
      float mx = fmaxf(fmaxf(s1[0], s1[1]), fmaxf(s1[2], s1[3]));
#pragma unroll
      for (int r = 4; r < 16; ++r) mx = fmaxf(mx, s1[r]);
      mx = fmaxf(mx, __shfl_xor(mx, 32));
      const float mn = fmaxf(m, mx);
      if (__builtin_amdgcn_ballot_w64(mn > m) != 0) {
        const float alpha = __builtin_amdgcn_exp2f(m - mn); lsum *= alpha; psA *= alpha;
#pragma unroll
        for (int r = 0; r < 16; ++r) s0[r] *= alpha;
#pragma unroll
        for (int d = 0; d < 4; ++d)
#pragma unroll
          for (int r = 0; r < 16; ++r) o[d][r] *= alpha;
      }
      m = mn;
    }
    lsum += psA;
    const bf16_t* vb = sV + lr * 72 + lh * 8;
#pragma unroll
    for (int sh = 0; sh < 2; ++sh) {
      const bf16x8 pf = pack8(s0[8 * sh + 0], s0[8 * sh + 1], s0[8 * sh + 2], s0[8 * sh + 3], s0[8 * sh + 4], s0[8 * sh + 5], s0[8 * sh + 6], s0[8 * sh + 7]);
#pragma unroll
      for (int d = 0; d < 4; ++d) { const bf16x8 af = *(const bf16x8*)(vb + d * 32 * 72 + sh * 16); o[d] = MFMA32(af, pf, o[d]); }
    }
    float psB = 0.f;
#pragma unroll
    for (int r = 0; r < 16; ++r) { const float e = __builtin_amdgcn_exp2f(s1[r] - m); s1[r] = e; psB += e; }
    lsum += psB;
#pragma unroll
    for (int sh = 0; sh < 2; ++sh) {
      const bf16x8 pf = pack8(s1[8 * sh + 0], s1[8 * sh + 1], s1[8 * sh + 2], s1[8 * sh + 3], s1[8 * sh + 4], s1[8 * sh + 5], s1[8 * sh + 6], s1[8 * sh + 7]);
#pragma unroll
      for (int d = 0; d < 4; ++d) { const bf16x8 af = *(const bf16x8*)(vb + d * 32 * 72 + 32 + sh * 16); o[d] = MFMA32(af, pf, o[d]); }
    }
  }
  const float lt = lsum + __shfl_xor(lsum, 32); const float inv = 1.f / lt;
  float ss = 0.f;
#pragma unroll
  for (int d = 0; d < 4; ++d)
#pragma unroll
    for (int r = 0; r < 16; ++r) { o[d][r] *= inv; ss += o[d][r] * o[d][r]; }
  ss += __shfl_xor(ss, 32);
  const float rstd = rsqrtf(ss * (1.f / 128.f) + 1e-6f);
  const int tt = b * S_ + qb * 128 + w * 32 + lr;
  bf16_t* mix = (bf16_t*)(ws + OFF_MIX) + (size_t)tt * 4096 + head * 128;
  const float* gn = p.attn_out_norm + head * 128;
#pragma unroll
  for (int d = 0; d < 4; ++d)
#pragma unroll
    for (int rg = 0; rg < 4; ++rg) {
      const int dd = d * 32 + 8 * rg + 4 * lh;
      float4 g = *(const float4*)(gn + dd); uint2 ov;
      ov.x = pack2(o[d][4 * rg + 0] * rstd * g.x, o[d][4 * rg + 1] * rstd * g.y); ov.y = pack2(o[d][4 * rg + 2] * rstd * g.z, o[d][4 * rg + 3] * rstd * g.w);
      *(uint2*)(mix + dd) = ov;
    }
}

__device__ __forceinline__ void ssd_out_tile(const Params& p, int tile, unsigned char* smem) {
  unsigned char* ws = p.ws;
  const int g = tile & 7, c = (tile >> 3) & 15, b = tile >> 7; const int t0 = b * S_ + c * 128;
  const int tid = opaque_tid(), lane = tid & 63, w = tid >> 6, lr = lane & 31, lh = lane >> 5;
  bf16_t* sC = (bf16_t*)smem;
  bf16_t* sB = sC + 128 * 136;
  bf16_t* sXT = sB;
  float* sAc = (float*)(sB + 64 * 132);
  float* sDt = sAc + 128;
  bf16_t* sH = (bf16_t*)(sDt + 128);
  const bf16_t* xc = (const bf16_t*)(ws + OFF_A);
  const bf16_t* proj = (const bf16_t*)(ws + OFF_B);
  __syncthreads();
#pragma unroll
  for (int i = 0; i < 8; ++i) {
    const int cidx = tid + 256 * i; const int row = cidx >> 4, nc = cidx & 15;
    *(uint4*)(sB + row * 136 + nc * 8) = *(const uint4*)(xc + (size_t)(t0 + row) * 4096 + 2048 + g * 128 + nc * 8);
    *(uint4*)(sC + row * 136 + nc * 8) = *(const uint4*)(xc + (size_t)(t0 + row) * 4096 + 3072 + g * 128 + nc * 8);
  }
  __syncthreads();
  const int l0 = 32 * w, lidx = l0 + lr;
  bf16x8 cfr[8];
#pragma unroll
  for (int ks = 0; ks < 8; ++ks) cfr[ks] = *(const bf16x8*)(sC + lidx * 136 + ks * 16 + lh * 8);
  f32x16 G[4];
#pragma unroll
  for (int st = 0; st < 4; ++st) {
#pragma unroll
    for (int r = 0; r < 16; ++r) G[st][r] = 0.f;
#pragma unroll
    for (int ks = 0; ks < 8; ++ks) {
      bf16x8 af = *(const bf16x8*)(sB + (st * 32 + lr) * 136 + ks * 16 + lh * 8);
      G[st] = MFMA32(af, cfr[ks], G[st]);
    }
  }
  const int tt = t0 + lidx;
  bf16_t* mixrow = (bf16_t*)(ws + OFF_MIX) + (size_t)tt * 4096 + 2048 + g * 256;
  float ssq = 0.f;
#pragma unroll 1
  for (int r = 0; r < 4; ++r) {
    const int hd = g * 4 + r;
    __syncthreads();
#pragma unroll
    for (int i = 0; i < 2; ++i) {
      const int item = tid + 256 * i; const int sp = item >> 3, pc = item & 7;
      uint4 v0 = *(const uint4*)(xc + (size_t)(t0 + 2 * sp) * 4096 + hd * 64 + pc * 8);
      uint4 v1 = *(const uint4*)(xc + (size_t)(t0 + 2 * sp + 1) * 4096 + hd * 64 + pc * 8);
      unsigned a0[4] = {v0.x, v0.y, v0.z, v0.w}, a1[4] = {v1.x, v1.y, v1.z, v1.w};
#pragma unroll
      for (int j = 0; j < 4; ++j) {
        *(unsigned*)(sXT + (pc * 8 + 2 * j) * 132 + 2 * sp) = (a0[j] & 0xffffu) | (a1[j] << 16);
        *(unsigned*)(sXT + (pc * 8 + 2 * j + 1) * 132 + 2 * sp) = (a0[j] >> 16) | (a1[j] & 0xffff0000u);
      }
    }
    f32x16 y[2];
#pragma unroll
    for (int pt = 0; pt < 2; ++pt)
#pragma unroll
      for (int rr = 0; rr < 16; ++rr) y[pt][rr] = 0.f;
#pragma unroll 1
    for (int dir = 0; dir < 2; ++dir) {
      const float* DT = (const float*)(ws + OFF_DT) + (size_t)dir * T_ * 32; const float* AC = (const float*)(ws + OFF_ACUM) + (size_t)dir * T_ * 32;
      const bf16_t* hin = (const bf16_t*)(ws + OFF_ST) + ((((size_t)(dir * 4 + b) * 16 + c) * 32 + hd) * 64) * 128;
      u32x4 hreg[4];
#pragma unroll
      for (int q = 0; q < 4; ++q) { const int cc = tid + 256 * q; hreg[q] = *(const u32x4*)(hin + (cc >> 4) * 128 + (cc & 15) * 8); }
      __syncthreads();
      if (tid < 128) { sAc[tid] = AC[(t0 + tid) * 32 + hd]; sDt[tid] = DT[(t0 + tid) * 32 + hd]; }
#pragma unroll
      for (int q = 0; q < 4; ++q) { const int cc = tid + 256 * q; *(u32x4*)(sH + (cc >> 4) * 136 + (cc & 15) * 8) = hreg[q]; }
      __syncthreads();
      const float acl = sAc[lidx];
      const int sgn = 1 - 2 * dir;
#pragma unroll
      for (int st = 0; st < 4; ++st)
#pragma unroll
        for (int sh = 0; sh < 2; ++sh) {
          const int sb0 = st * 32 + sh * 16 + lh * 4;
          float4 a0 = *(const float4*)(sAc + sb0), a1 = *(const float4*)(sAc + sb0 + 8);
          float4 d0 = *(const float4*)(sDt + sb0), d1 = *(const float4*)(sDt + sb0 + 8);
          float av[8] = {a0.x, a0.y, a0.z, a0.w, a1.x, a1.y, a1.z, a1.w};
          float dv[8] = {d0.x, d0.y, d0.z, d0.w, d1.x, d1.y, d1.z, d1.w};
          float mv[8];
#pragma unroll
          for (int j = 0; j < 8; ++j) {
            const int sidx = sb0 + (j & 3) + 8 * (j >> 2);
            const float ex = ((lidx - sidx) * sgn >= 0) ? (acl - av[j]) : -INFINITY;
            mv[j] = G[st][8 * sh + j] * (__expf(ex) * dv[j]);
          }
          bf16x8 mf = pack8(mv[0], mv[1], mv[2], mv[3], mv[4], mv[5], mv[6], mv[7]);
#pragma unroll
          for (int pt = 0; pt < 2; ++pt) {
            const bf16_t* xrow = sXT + (pt * 32 + lr) * 132 + sb0;
            bf16x8 af = mk8(*(const uint2*)xrow, *(const uint2*)(xrow + 8));
            y[pt] = MFMA32(af, mf, y[pt]);
          }
        }
      f32x16 yo[2];
#pragma unroll
      for (int pt = 0; pt < 2; ++pt)
#pragma unroll
        for (int rr = 0; rr < 16; ++rr) yo[pt][rr] = 0.f;
#pragma unroll
      for (int ks = 0; ks < 8; ++ks)
#pragma unroll
        for (int pt = 0; pt < 2; ++pt) {
          bf16x8 hf = *(const bf16x8*)(sH + (pt * 32 + lr) * 136 + ks * 16 + lh * 8);
          yo[pt] = MFMA32(hf, cfr[ks], yo[pt]);
        }
      const float el = expf(acl);
#pragma unroll
      for (int pt = 0; pt < 2; ++pt)
#pragma unroll
        for (int rr = 0; rr < 16; ++rr) y[pt][rr] += el * yo[pt][rr];
    }
    const float dsk = p.d_skip[hd];
#pragma unroll
    for (int pt = 0; pt < 2; ++pt)
#pragma unroll
      for (int rg = 0; rg < 4; ++rg) {
        const int pp = pt * 32 + 8 * rg + 4 * lh; const int ch = hd * 64 + pp;
        uint2 xv = *(const uint2*)(xc + (size_t)tt * 4096 + ch);
        uint2 zv = *(const uint2*)(proj + (size_t)tt * PJW + 1600 + ch);
        float xs4[4] = {bflo(xv.x), bfhi(xv.x), bflo(xv.y), bfhi(xv.y)};
        float zs4[4] = {bflo(zv.x), bfhi(zv.x), bflo(zv.y), bfhi(zv.y)};
        float yv[4];
#pragma unroll
        for (int j = 0; j < 4; ++j) { float v = y[pt][4 * rg + j] + dsk * xs4[j]; v *= zs4[j] / (1.f + __expf(-zs4[j])); yv[j] = v; ssq += v * v; }
        uint2 ov; ov.x = pack2(yv[0], yv[1]); ov.y = pack2(yv[2], yv[3]);
        *(uint2*)(mixrow + r * 64 + pp) = ov;
      }
  }
  ssq += __shfl_xor(ssq, 32);
  const float rstd = rsqrtf(ssq * (1.f / 256.f) + 1e-6f);
  __threadfence_block();
#pragma unroll
  for (int r = 0; r < 4; ++r)
#pragma unroll
    for (int pt = 0; pt < 2; ++pt)
#pragma unroll
      for (int rg = 0; rg < 4; ++rg) {
        const int pp = pt * 32 + 8 * rg + 4 * lh;
        uint2 v = *(uint2*)(mixrow + r * 64 + pp);
        float4 gn = *(const float4*)(p.ssm_out_norm + g * 256 + r * 64 + pp);
        uint2 ov; ov.x = pack2(bflo(v.x) * rstd * gn.x, bfhi(v.x) * rstd * gn.y); ov.y = pack2(bflo(v.y) * rstd * gn.z, bfhi(v.y) * rstd * gn.w);
        *(uint2*)(mixrow + r * 64 + pp) = ov;
      }
}

__device__ __forceinline__ void phase5(const Params& p, unsigned char* smem) {
  const int xcd = blockIdx.x & 7, local = blockIdx.x >> 3, nloc = gridDim.x >> 3;
  if (gridDim.x == 512) {
    const int upper = (local >= 32) ? 1 : 0;
    if (upper) fp8_convert_tiles(p, FP8_EARLY + blockIdx.x - 256, 256);
    const int nat = upper ? 1 : 3;
#pragma unroll 1
    for (int j = 0; j < nat; ++j) {
      const int idx = upper ? (96 + local - 32) : (local + 32 * j);
      attn_tile(p, ((idx >> 6) * 8 + xcd) * 64 + (idx & 63), smem);
    }
  } else {
    for (int idx = local; idx < 128; idx += nloc) attn_tile(p, ((idx >> 6) * 8 + xcd) * 64 + (idx & 63), smem);
  }
  for (int t = blockIdx.x; t < 512; t += gridDim.x) ssd_out_tile(p, t, smem);
}

__device__ __forceinline__ void phase6(const Params& p, unsigned char* smem) {
  unsigned char* ws = p.ws;
  EpiOut epi{p.x, p.out};
  const bf16_t* A = (const bf16_t*)(ws + OFF_MIX); const bf16_t* B = (const bf16_t*)(ws + OFF_WOUT);
  for_gemm_tiles(T_ / GBM, 32, [&](int mt, int nt) { gemm_tile<GBM, GNST>(A, 4096, B, 4096, 4096, mt * GBM, nt * 128, smem, epi); });
}

__device__ __forceinline__ void phase7(const Params& p, unsigned char* smem) {
  unsigned char* ws = p.ws; const int tid = opaque_tid(); const int lane = tid & 63, w = tid >> 6;
  for (int t = blockIdx.x; t < T_ / 4; t += gridDim.x) {
    const int row = t * 4 + w;
    rms_row_f32<4096>(p.out + (size_t)row * D_, p.norm_ffn, (bf16_t*)(ws + OFF_A) + (size_t)row * D_, lane);
  }
}

__device__ __forceinline__ void phase8(const Params& p, unsigned char* smem) {
  unsigned char* ws = p.ws;
  EpiBf16 epi{(bf16_t*)(ws + OFF_QP), 2048};
  const bf16_t* A = (const bf16_t*)(ws + OFF_A); const bf16_t* B = (const bf16_t*)(ws + OFF_WQ);
  for_gemm_tiles(T_ / GBM, 16, [&](int mt, int nt) { gemm_tile<GBM, GNST>(A, 4096, B, 4096, 4096, mt * GBM, nt * 128, smem, epi); });
}

__device__ __forceinline__ void phase9(const Params& p, unsigned char* smem) {
  unsigned char* ws = p.ws;
  EpiF32 epi{(float*)(ws + OFF_SC), 2048};
  const bf16_t* A = (const bf16_t*)(ws + OFF_QP); const bf16_t* B = (const bf16_t*)(ws + OFF_SK);
  for (int t = blockIdx.x; t < 1024; t += gridDim.x) {
    const int blk = t & 15, mt = t >> 4;
    gemm_tile<128, 4>(A + blk * 128, 2048, B, 128, 128, mt * 128, blk * 128, smem, epi);
  }
}

#define WAVE_LDS_FENCE() asm volatile("s_waitcnt lgkmcnt(0)" ::: "memory")
#define WAVE_LDS_FENCE() asm volatile("s_waitcnt lgkmcnt(0)" ::: "memory")
__device__ __forceinline__ void topk16_rank(const float a, const float b, int lane, unsigned* skey, float* tv, int* ti) {
  const unsigned ka = (fkey(a) & ~127u) | (unsigned)(127 - lane), kb = (fkey(b) & ~127u) | (unsigned)(63 - lane);
  unsigned T = 0u;
#pragma unroll
  for (int bit = 31; bit >= 0; --bit) {
    const unsigned c = T | (1u << bit);
    const int cnt = __builtin_popcountll(__builtin_amdgcn_ballot_w64(ka >= c)) + __builtin_popcountll(__builtin_amdgcn_ballot_w64(kb >= c));
    T = (cnt >= 16) ? c : T;
  }
  const bool sa = ka >= T, sb = kb >= T;
  const unsigned long long ma = __builtin_amdgcn_ballot_w64(sa), mb = __builtin_amdgcn_ballot_w64(sb);
  const int pa = (int)__builtin_amdgcn_mbcnt_hi((unsigned)(ma >> 32), __builtin_amdgcn_mbcnt_lo((unsigned)ma, 0u));
  const int pb = __builtin_popcountll(ma) + (int)__builtin_amdgcn_mbcnt_hi((unsigned)(mb >> 32), __builtin_amdgcn_mbcnt_lo((unsigned)mb, 0u));
  float* sval = (float*)(skey + 16); int* sidx = (int*)(skey + 32);
  if (sa) { skey[pa & 15] = ka; sval[pa & 15] = a; sidx[pa & 15] = lane; }
  if (sb) { skey[pb & 15] = kb; sval[pb & 15] = b; sidx[pb & 15] = lane + 64; }
  WAVE_LDS_FENCE();
  {
    const unsigned mk = skey[lane & 15]; const float mv = sval[lane & 15]; const int mi = sidx[lane & 15];
    int rank = 0;
#pragma unroll
    for (int j4 = 0; j4 < 4; ++j4) {
      const u32x4 x = *(const u32x4*)(skey + 4 * j4);
#pragma unroll
      for (int e = 0; e < 4; ++e) rank += (x[e] > mk) ? 1 : 0;
    }
    if (lane < 16) { tv[rank] = mv; ti[rank] = mi; }
  }
  WAVE_LDS_FENCE();
}

__device__ __forceinline__ void peer_fma(const u32x4 (&u)[4], const unsigned (&hvp)[32], float& dot) {
#pragma unroll
  for (int i = 0; i < 4; ++i)
#pragma unroll
    for (int q = 0; q < 4; ++q) {
      const int wd = (int)u[i][q];
      const f32x2_t lo = __builtin_amdgcn_cvt_pk_f32_fp8(wd, false), hi = __builtin_amdgcn_cvt_pk_f32_fp8(wd, true);
      const unsigned h0 = hvp[8 * i + 2 * q], h1 = hvp[8 * i + 2 * q + 1];
      dot += lo[0] * bflo(h0) + lo[1] * bfhi(h0) + hi[0] * bflo(h1) + hi[1] * bfhi(h1);
    }
}
__device__ __forceinline__ void peer_axpy(const u32x4 (&v)[4], float coef, float (&acc)[64]) {
#pragma unroll
  for (int i = 0; i < 4; ++i)
#pragma unroll
    for (int q = 0; q < 4; ++q) {
      const int wd = (int)v[i][q];
      const f32x2_t lo = __builtin_amdgcn_cvt_pk_f32_fp8(wd, false), hi = __builtin_amdgcn_cvt_pk_f32_fp8(wd, true);
      acc[16 * i + 4 * q] += coef * lo[0]; acc[16 * i + 4 * q + 1] += coef * lo[1]; acc[16 * i + 4 * q + 2] += coef * hi[0]; acc[16 * i + 4 * q + 3] += coef * hi[1];
    }
}

__device__ __forceinline__ void phase10(const Params& p, unsigned char* smem) {
  unsigned char* ws = p.ws; const int tid = opaque_tid(), lane = tid & 63, w = tid >> 6;
  unsigned char* wb = smem + w * 4096;
  unsigned* skey = (unsigned*)wb;
  float* tv = (float*)(wb + 512);
  int* ti = (int*)(wb + 640);
  float* cs = (float*)(wb + 768);
  int* cf = (int*)(wb + 1024);
  float* ts = (float*)(wb + 1280);
  int* te = (int*)(wb + 1344);
  int* s_idx = (int*)(wb + 1536);
  float* s_gate = (float*)(wb + 2048);
  const float* SC = (const float*)(ws + OFF_SC); const bf16_t* hn = (const bf16_t*)(ws + OFF_A);
  const unsigned char* EU = ws + OFF_EU8; const unsigned char* EV = ws + OFF_EV8;
  const float* SU = (const float*)(ws + OFF_ESC); const float* SV = SU + 16384;
  int ci = 0, cj = 0;
  { int cnt = 0;
#pragma unroll
    for (int i = 0; i < 16; ++i) { const int n = 16 / (i + 1); if (lane >= cnt && lane < cnt + n) { ci = i; cj = lane - cnt; } cnt += n; } }
  for (int t = blockIdx.x; t < T_ / 4; t += gridDim.x) {
    const int tt = t * 4 + w;
    WAVE_LDS_FENCE();
    float sca[16], scb[16];
#pragma unroll
    for (int l = 0; l < 16; ++l) { sca[l] = SC[(size_t)tt * 2048 + l * 128 + lane]; scb[l] = SC[(size_t)tt * 2048 + l * 128 + 64 + lane]; }
#pragma unroll
    for (int h = 0; h < 8; ++h) {
      topk16_rank(sca[2 * h], scb[2 * h], lane, skey, tv, ti);
      topk16_rank(sca[2 * h + 1], scb[2 * h + 1], lane, skey, tv + 16, ti + 16);
      const float c = (lane < 50) ? tv[ci] + tv[16 + cj] : -INFINITY; const int fl = ci * 16 + cj;
      cs[lane] = c; cf[lane] = fl;
      WAVE_LDS_FENCE();
      int rank = 0;
#pragma unroll
      for (int l4 = 0; l4 < 13; ++l4) {
        const float4 c4 = *(const float4*)(cs + 4 * l4); const int4 f4 = *(const int4*)(cf + 4 * l4);
        rank += (c4.x > c || (c4.x == c && f4.x < fl)) ? 1 : 0; rank += (c4.y > c || (c4.y == c && f4.y < fl)) ? 1 : 0;
        rank += (c4.z > c || (c4.z == c && f4.z < fl)) ? 1 : 0; rank += (c4.w > c || (c4.w == c && f4.w < fl)) ? 1 : 0;
      }
      if (lane < 50 && rank < 16) { ts[rank] = c; te[rank] = ti[ci] * 128 + ti[16 + cj]; }
      WAVE_LDS_FENCE();
      const float tsv = ts[lane & 15]; const float ex = expf(tsv - ts[0]);
      float sum = ex; sum += __shfl_xor(sum, 8); sum += __shfl_xor(sum, 4); sum += __shfl_xor(sum, 2); sum += __shfl_xor(sum, 1);
      if (lane < 16) { s_idx[h * 16 + lane] = te[lane]; s_gate[h * 16 + lane] = ex / sum; }
    }
    WAVE_LDS_FENCE();
    unsigned hv[32]; float acc[64];
#pragma unroll
    for (int i = 0; i < 4; ++i) {
      const u32x4 h0 = *(const u32x4*)(hn + (size_t)tt * 4096 + 16 * (lane + 64 * i)), h1 = *(const u32x4*)(hn + (size_t)tt * 4096 + 16 * (lane + 64 * i) + 8);
#pragma unroll
      for (int q = 0; q < 4; ++q) { hv[8 * i + q] = h0[q]; hv[8 * i + 4 + q] = h1[q]; }
    }
#pragma unroll
    for (int i = 0; i < 64; ++i) acc[i] = 0.f;
    u32x4 ua[4], va[4], ub[4], vb[4];
    { const int idx = __builtin_amdgcn_readfirstlane(s_idx[0]);
#pragma unroll
      for (int i = 0; i < 4; ++i) { ua[i] = *(const u32x4*)(EU + (size_t)idx * 4096 + 16 * (lane + 64 * i)); va[i] = *(const u32x4*)(EV + (size_t)idx * 4096 + 16 * (lane + 64 * i)); } }
#pragma unroll 1
    for (int k = 0; k < 128; k += 2) {
      const int idxb = __builtin_amdgcn_readfirstlane(s_idx[k + 1]);
#pragma unroll
      for (int i = 0; i < 4; ++i) { ub[i] = *(const u32x4*)(EU + (size_t)idxb * 4096 + 16 * (lane + 64 * i)); vb[i] = *(const u32x4*)(EV + (size_t)idxb * 4096 + 16 * (lane + 64 * i)); }
      { const int idx = __builtin_amdgcn_readfirstlane(s_idx[k]); const float gt = s_gate[k];
        float dot = 0.f; peer_fma(ua, hv, dot);
        dot = wave_sum_fast(dot) * SU[idx];
        const float act = dot / (1.f + __expf(-1.5957691216057308f * (dot + 0.044715f * dot * dot * dot)));
        peer_axpy(va, gt * act * SV[idx], acc); }
      if (k + 2 < 128) {
        const int idxa = __builtin_amdgcn_readfirstlane(s_idx[k + 2]);
#pragma unroll
        for (int i = 0; i < 4; ++i) { ua[i] = *(const u32x4*)(EU + (size_t)idxa * 4096 + 16 * (lane + 64 * i)); va[i] = *(const u32x4*)(EV + (size_t)idxa * 4096 + 16 * (lane + 64 * i)); }
      }
      { const float gt = s_gate[k + 1];
        float dot = 0.f; peer_fma(ub, hv, dot);
        dot = wave_sum_fast(dot) * SU[idxb];
        const float act = dot / (1.f + __expf(-1.5957691216057308f * (dot + 0.044715f * dot * dot * dot)));
        peer_axpy(vb, gt * act * SV[idxb], acc); }
    }
    float4* op = (float4*)(p.out + (size_t)tt * D_);
#pragma unroll
    for (int i = 0; i < 4; ++i)
#pragma unroll
      for (int q = 0; q < 4; ++q) {
        float4 o = op[(lane + 64 * i) * 4 + q];
        o.x += acc[16 * i + 4 * q]; o.y += acc[16 * i + 4 * q + 1]; o.z += acc[16 * i + 4 * q + 2]; o.w += acc[16 * i + 4 * q + 3];
        op[(lane + 64 * i) * 4 + q] = o;
      }
  }
}


#define XB_TMO      128
#define XB_XCNT(j)  (256  + 64 * (j))
#define XB_XSUB(j)  (1280 + 64 * (j))
#define XB_XGEN(j)  (2304 + 64 * (j))
#define XB_TOP      3328
#define XB_TOPGEN   3392
#define XB_SPIN_CAP (1u << 18)
__device__ __forceinline__ unsigned xb_ld(unsigned* q)              { return __hip_atomic_load(q, __ATOMIC_RELAXED, __HIP_MEMORY_SCOPE_AGENT); }
__device__ __forceinline__ unsigned xb_add(unsigned* q, unsigned v) { return __hip_atomic_fetch_add(q, v, __ATOMIC_RELAXED, __HIP_MEMORY_SCOPE_AGENT); }
__device__ __forceinline__ unsigned xb_xcc_id() { return (unsigned)__builtin_amdgcn_s_getreg((3 << 11) | 20) & 0xFu; }
#define XB_SPIN(cond, bar) do { unsigned _sp = 0; while (cond) { __builtin_amdgcn_s_sleep(1); \
    if ((++_sp & 255u) == 0u) { if (xb_ld(&(bar)[XB_TMO])) break; if (_sp > XB_SPIN_CAP) { atomicAdd(&(bar)[XB_TMO], 1u); break; } } } } while (0)
struct XcdBarrier { unsigned* bar; unsigned x; volatile unsigned* st; };
__device__ __forceinline__ XcdBarrier xcd_barrier_post(unsigned* bar, volatile unsigned* st) {
  XcdBarrier b; b.bar = bar; b.x = xb_xcc_id(); b.st = st;
  if (threadIdx.x == 0) (void)xb_add(&bar[XB_XCNT(b.x)], 1u);
  return b;
}
__device__ __forceinline__ void xcd_barrier_complete(unsigned* bar, unsigned x, unsigned& nloc, unsigned& nx) {
  const unsigned G = gridDim.x * gridDim.y * gridDim.z;
  unsigned sum, cnt, mine, sp = 0u;
  for (;;) {
    sum = 0u; cnt = 0u; mine = 0u;
#pragma unroll
    for (unsigned j = 0; j < 16; ++j) { const unsigned c = xb_ld(&bar[XB_XCNT(j)]); sum += c; cnt += (c > 0u) ? 1u : 0u; mine = (j == x) ? c : mine; }
    if (sum == G) break;
    __builtin_amdgcn_s_sleep(1);
    if ((++sp & 255u) == 0u) { if (xb_ld(&bar[XB_TMO])) break; if (sp > XB_SPIN_CAP) { atomicAdd(&bar[XB_TMO], 1u); break; } }
  }
  nloc = mine > 0u ? mine : 1u; nx = cnt > 0u ? cnt : 1u;
}
__device__ __forceinline__ void xcd_barrier(const XcdBarrier& b) {
  asm volatile("s_waitcnt vmcnt(0)" ::: "memory");
  __syncthreads();
  if (threadIdx.x == 0) {
    unsigned* bar = b.bar;
    __builtin_amdgcn_s_waitcnt(0);
    unsigned nloc = b.st[0], nx = b.st[1];
    if (nloc == 0u) { xcd_barrier_complete(bar, b.x, nloc, nx); b.st[0] = nloc; b.st[1] = nx; }
    const unsigned old = xb_add(&bar[XB_XSUB(b.x)], 1u);
    const unsigned gen = old / nloc;
    if (old + 1u == (gen + 1u) * nloc) {
      __builtin_amdgcn_fence(__ATOMIC_RELEASE, "agent");
      asm volatile("s_waitcnt vmcnt(0)" ::: "memory");
      const unsigned og = xb_add(&bar[XB_TOP], 1u);
      const unsigned tg = og / nx;
      if (og + 1u == (tg + 1u) * nx) xb_add(&bar[XB_TOPGEN], 1u);
      else XB_SPIN(xb_ld(&bar[XB_TOPGEN]) == tg, bar);
      __builtin_amdgcn_fence(__ATOMIC_ACQUIRE, "agent");
      xb_add(&bar[XB_XGEN(b.x)], 1u);
      asm volatile("s_waitcnt vmcnt(0)" ::: "memory");
    } else {
      XB_SPIN(xb_ld(&bar[XB_XGEN(b.x)]) == gen, bar);
      __builtin_amdgcn_fence(__ATOMIC_ACQUIRE, "agent");
      asm volatile("s_waitcnt vmcnt(0)" ::: "memory");
    }
  }
  __syncthreads();
}

#ifndef PROBE_DUP
#define PROBE_DUP 0
#endif
#define RUN_PHASE(n) if (lo <= n && n < hi) { if (n > lo) xcd_barrier(xb); phase##n(p, smem); }
__global__ void __launch_bounds__(256, 2) fwd_megakernel(Params p) {
  extern __shared__ __attribute__((aligned(16))) unsigned char smem[];
  const int lo = (int)p.ph_lo, hi = (int)p.ph_hi;
  volatile unsigned* st = (volatile unsigned*)(smem + LDS_BYTES - 16);
  if (threadIdx.x < 2) st[threadIdx.x] = 0u;
  __syncthreads();
  XcdBarrier xb = xcd_barrier_post((unsigned*)(p.ws + OFF_BAR), st);
  if (hi > 1000) cg::this_grid().sync();
  RUN_PHASE(0) RUN_PHASE(1) RUN_PHASE(2) RUN_PHASE(3) RUN_PHASE(4) RUN_PHASE(5)
  RUN_PHASE(6) RUN_PHASE(7) RUN_PHASE(8) RUN_PHASE(9) RUN_PHASE(10)
}

extern "C" void kernel_launch(void* const* d_in, const int* in_sizes, int n_in, void* d_out, int out_size, void* d_ws, size_t ws_size,
                              hipStream_t stream) {
  static int grid_blocks = 0;
  if (!grid_blocks) {
    if (ws_size < OFF_END) { fprintf(stderr, "kernel_launch: workspace too small (%zu < %zu)\n", ws_size, (size_t)OFF_END); grid_blocks = -1; return; }
    int dev = 0, cus = 0, per_cu = 0;
    hipGetDevice(&dev);
    hipDeviceGetAttribute(&cus, hipDeviceAttributeMultiprocessorCount, dev);
    if (hipFuncSetAttribute((const void*)fwd_megakernel, hipFuncAttributeMaxDynamicSharedMemorySize, LDS_BYTES) != hipSuccess) { fprintf(stderr, "kernel_launch: hipFuncSetAttribute failed\n"); grid_blocks = -1; return; }
    hipOccupancyMaxActiveBlocksPerMultiprocessor(&per_cu, (const void*)fwd_megakernel, 256, LDS_BYTES);
    if (per_cu < 1) { fprintf(stderr, "kernel_launch: occupancy query returned %d\n", per_cu); per_cu = 1; }
    if (per_cu > 2) per_cu = 2;
    grid_blocks = cus * per_cu;
  }
  if (grid_blocks < 0) return;
  Params p{};
  p.x = (const float*)d_in[0]; p.pos = (const int*)d_in[1]; p.norm_mix = (const float*)d_in[2]; p.w_in = (const float*)d_in[3];
  p.q_a_norm = (const float*)d_in[4]; p.w_uq = (const float*)d_in[5]; p.kv_a_norm = (const float*)d_in[6]; p.w_ukv = (const float*)d_in[7];
  p.q_norm = (const float*)d_in[8]; p.k_norm = (const float*)d_in[9]; p.attn_out_norm = (const float*)d_in[10]; p.conv_w = (const float*)d_in[11];
  p.conv_b = (const float*)d_in[12]; p.a_log_f = (const float*)d_in[13]; p.a_log_b = (const float*)d_in[14]; p.dt_bias_f = (const float*)d_in[15];
  p.dt_bias_b = (const float*)d_in[16]; p.d_skip = (const float*)d_in[17]; p.ssm_out_norm = (const float*)d_in[18]; p.w_out = (const float*)d_in[19];
  p.norm_ffn = (const float*)d_in[20]; p.w_query = (const float*)d_in[21]; p.sub_keys = (const float*)d_in[22]; p.expert_u = (const float*)d_in[23];
  p.expert_v = (const float*)d_in[24];
  p.out = (float*)d_out; p.ws = (unsigned char*)d_ws;
#if ONE_LAUNCH
  p.ph_lo = 0; p.ph_hi = NPHASE;
  if (hipMemsetAsync((unsigned char*)d_ws + OFF_BAR, 0, BAR_BYTES, stream) != hipSuccess) { fprintf(stderr, "kernel_launch: hipMemsetAsync failed\n"); return; }
  void* args[] = {&p};
  hipError_t e = hipLaunchCooperativeKernel((const void*)fwd_megakernel, dim3(grid_blocks), dim3(256), args, LDS_BYTES, stream);
  if (e != hipSuccess) fprintf(stderr, "cooperative launch failed: %s (grid %d)\n", hipGetErrorString(e), grid_blocks);
#else
  for (int ph = 0; ph < NPHASE; ++ph) {
    p.ph_lo = ph; p.ph_hi = ph + 1;
    hipLaunchKernelGGL(fwd_megakernel, dim3(grid_blocks), dim3(256), LDS_BYTES, stream, p);
  }
#endif
}
```

```cpp
#include <hip/hip_runtime.h>
#include <hip/hip_cooperative_groups.h>
#include <cstdio>
#include <cstdint>
namespace cg = cooperative_groups;

typedef unsigned short bf16_t;
typedef __attribute__((ext_vector_type(8))) short bf16x8;
typedef __attribute__((ext_vector_type(4))) float f32x4;
typedef __attribute__((ext_vector_type(16))) float f32x16;
typedef __attribute__((ext_vector_type(4))) unsigned u32x4;
typedef __attribute__((ext_vector_type(2))) unsigned u32x2;

#ifndef ONE_LAUNCH
#define ONE_LAUNCH 1
#endif

constexpr int T_ = 8192, S_ = 2048, D_ = 4096, PJW = 7744;
constexpr int NPHASE = 11;
constexpr int FP8_EARLY = 3328;
constexpr int LDS_BYTES = 73728 + 256;
#ifndef GBM
#define GBM 256
#endif
#ifndef GNST
#define GNST 3
#endif

constexpr size_t SZ_WIN = (size_t)7808 * 4096 * 2, SZ_WUQ = (size_t)3072 * 1024 * 2, SZ_WUKV = (size_t)4096 * 512 * 2,
                 SZ_WOUT = (size_t)4096 * 4096 * 2, SZ_WQ = (size_t)2048 * 4096 * 2, SZ_SK = (size_t)16 * 128 * 128 * 2;
constexpr size_t OFF_WIN = 0, OFF_WUQ = OFF_WIN + SZ_WIN, OFF_WUKV = OFF_WUQ + SZ_WUQ, OFF_WOUT = OFF_WUKV + SZ_WUKV,
                 OFF_WQ = OFF_WOUT + SZ_WOUT, OFF_SK = OFF_WQ + SZ_WQ;
constexpr size_t OFF_A = OFF_SK + SZ_SK;
constexpr size_t OFF_B = OFF_A + (size_t)T_ * 4096 * 2;
constexpr size_t OFF_DTRAW = OFF_B + (size_t)T_ * PJW * 2;
constexpr size_t OFF_DT = OFF_DTRAW + (size_t)T_ * 64 * 4;
constexpr size_t OFF_ACUM = OFF_DT + (size_t)2 * T_ * 32 * 4;
constexpr size_t OFF_CQN = OFF_ACUM + (size_t)2 * T_ * 32 * 4;
constexpr size_t OFF_CKVN = OFF_CQN + (size_t)T_ * 1024 * 2;
constexpr size_t OFF_QRAW = OFF_CKVN + (size_t)T_ * 512 * 2;
constexpr size_t OFF_KVRAW = OFF_QRAW + (size_t)T_ * 3072 * 2;
constexpr size_t OFF_ST = OFF_KVRAW + (size_t)T_ * 4096 * 2;
constexpr size_t OFF_Q = OFF_ST + (size_t)2 * 4 * 16 * 32 * 64 * 128 * 2;
constexpr size_t OFF_K = OFF_Q + (size_t)4 * 16 * 2048 * 192 * 2;
constexpr size_t OFF_VT = OFF_K + (size_t)4 * 16 * 2048 * 192 * 2;
constexpr size_t OFF_EU8 = OFF_VT + (size_t)4 * 16 * 128 * 2048 * 2;
constexpr size_t OFF_EV8 = OFF_EU8 + (size_t)16384 * 4096;
constexpr size_t OFF_ESC = OFF_EV8 + (size_t)16384 * 4096;
constexpr size_t OFF_BAR = OFF_ESC + (size_t)2 * 16384 * 4;
constexpr size_t BAR_BYTES = 3456 * 4;
constexpr size_t OFF_END = OFF_BAR + 16384;
constexpr size_t OFF_QP = OFF_B;
constexpr size_t OFF_SC = OFF_B + (size_t)T_ * 2048 * 2;
constexpr size_t OFF_MIX = OFF_QRAW;

struct Params {
  const float* x; const int* pos; const float* norm_mix; const float* w_in; const float* q_a_norm; const float* w_uq;
  const float* kv_a_norm; const float* w_ukv; const float* q_norm; const float* k_norm; const float* attn_out_norm;
  const float* conv_w; const float* conv_b; const float* a_log_f; const float* a_log_b; const float* dt_bias_f; const float* dt_bias_b;
  const float* d_skip; const float* ssm_out_norm; const float* w_out; const float* norm_ffn; const float* w_query; const float* sub_keys;
  const float* expert_u; const float* expert_v;
  float* out; unsigned char* ws;
  long long ph_lo, ph_hi;
};

typedef __bf16 hwbf16x2 __attribute__((ext_vector_type(2)));
typedef float hwf32x2 __attribute__((ext_vector_type(2)));
__device__ __forceinline__ unsigned short f2bf(float f) { return __builtin_bit_cast(unsigned short, (__bf16)f); }
__device__ __forceinline__ float bf2f(unsigned short h) { return __uint_as_float(((unsigned)h) << 16); }
__device__ __forceinline__ unsigned pack2(float a, float b) { hwf32x2 f = {a, b}; return __builtin_bit_cast(unsigned, __builtin_convertvector(f, hwbf16x2)); }
__device__ __forceinline__ float bflo(unsigned u) { return __uint_as_float(u << 16); }
__device__ __forceinline__ float bfhi(unsigned u) { return __uint_as_float(u & 0xffff0000u); }
union U4B8 { uint4 u; bf16x8 v; };
__device__ __forceinline__ bf16x8 pack8(float a0, float a1, float a2, float a3, float a4, float a5, float a6, float a7) {
  U4B8 x; x.u = make_uint4(pack2(a0, a1), pack2(a2, a3), pack2(a4, a5), pack2(a6, a7)); return x.v;
}
__device__ __forceinline__ bf16x8 mk8(uint2 lo, uint2 hi) { U4B8 x; x.u = make_uint4(lo.x, lo.y, hi.x, hi.y); return x.v; }
__device__ __forceinline__ float wave_sum(float v) {
#pragma unroll
  for (int o = 32; o; o >>= 1) v += __shfl_xor(v, o);
  return v;
}
__device__ __forceinline__ void wave_argmax(float& v, int& i) {
#pragma unroll
  for (int o = 32; o; o >>= 1) {
    float ov = __shfl_xor(v, o); int oi = __shfl_xor(i, o);
    if (ov > v || (ov == v && oi < i)) { v = ov; i = oi; }
  }
}
__device__ __forceinline__ int opaque_tid() { int t = threadIdx.x; asm volatile("" : "+v"(t)); return t; }
__device__ __forceinline__ unsigned char* opaque_ptr(unsigned char* q) { asm volatile("" : "+s"(q)); return q; }
typedef float f32x2_t __attribute__((ext_vector_type(2)));
template <int CTRL> __device__ __forceinline__ float dppx(float v) { return __int_as_float(__builtin_amdgcn_update_dpp(0, __float_as_int(v), CTRL, 0xF, 0xF, true)); }
__device__ __forceinline__ float wave_sum_fast(float v) {
  v += dppx<0xB1>(v); v += dppx<0x4E>(v); v += dppx<0x141>(v); v += dppx<0x140>(v);
  const int iv = __float_as_int(v);
  return __int_as_float(__builtin_amdgcn_readlane(iv, 0)) + __int_as_float(__builtin_amdgcn_readlane(iv, 16)) +
         __int_as_float(__builtin_amdgcn_readlane(iv, 32)) + __int_as_float(__builtin_amdgcn_readlane(iv, 48));
}
__device__ __forceinline__ unsigned fkey(float f) { unsigned u = __float_as_uint(f); return (u & 0x80000000u) ? ~u : (u | 0x80000000u); }
__device__ __forceinline__ void fp8_row(const float* __restrict__ src, unsigned char* __restrict__ dst, float* __restrict__ scale_out, int lane) {
  float4 v[16]; float amax = 0.f;
#pragma unroll
  for (int j = 0; j < 16; ++j) {
    float4 t = ((const float4*)src)[lane + 64 * j]; v[j] = t;
    amax = fmaxf(amax, fmaxf(fmaxf(fabsf(t.x), fabsf(t.y)), fmaxf(fabsf(t.z), fabsf(t.w))));
  }
#pragma unroll
  for (int o = 32; o; o >>= 1) amax = fmaxf(amax, __shfl_xor(amax, o));
  const float sc = amax > 0.f ? 256.f / amax : 1.f;
  if (lane == 0) *scale_out = amax > 0.f ? amax * (1.f / 256.f) : 1.f;
#pragma unroll
  for (int j = 0; j < 16; ++j) {
    const float4 t = v[j];
    int wd = __builtin_amdgcn_cvt_pk_fp8_f32(t.x * sc, t.y * sc, 0, false);
    wd = __builtin_amdgcn_cvt_pk_fp8_f32(t.z * sc, t.w * sc, wd, true);
    ((unsigned*)dst)[lane + 64 * j] = (unsigned)wd;
  }
}
#define MFMA16(a, b, c) __builtin_amdgcn_mfma_f32_16x16x32_bf16(a, b, c, 0, 0, 0)
#define MFMA32(a, b, c) __builtin_amdgcn_mfma_f32_32x32x16_bf16(a, b, c, 0, 0, 0)

__device__ __forceinline__ void transpose_tile(const float* __restrict__ W, int K, int N, bf16_t* __restrict__ Wt, int tile, float* sm) {
  const int ntn = N >> 7; const int tk = tile / ntn, tn = tile - tk * ntn; const int k0 = tk << 6, n0 = tn << 7; const int tid = opaque_tid();
  float4 v[8];
#pragma unroll
  for (int i = 0; i < 8; ++i) v[i] = *(const float4*)(W + (size_t)(k0 + (tid >> 5) + 8 * i) * N + n0 + (tid & 31) * 4);
#pragma unroll
  for (int i = 0; i < 8; ++i) { float* d = sm + ((tid >> 5) + 8 * i) * 129 + (tid & 31) * 4; d[0] = v[i].x; d[1] = v[i].y; d[2] = v[i].z; d[3] = v[i].w; }
  __syncthreads();
#pragma unroll
  for (int i = 0; i < 4; ++i) {
    const int n = (tid >> 3) + 32 * i, kc = tid & 7; const float* s = sm + (kc * 8) * 129 + n;
    uint4 o; o.x = pack2(s[0], s[129]); o.y = pack2(s[258], s[387]); o.z = pack2(s[516], s[645]); o.w = pack2(s[774], s[903]);
    *(uint4*)(Wt + (size_t)(n0 + n) * K + k0 + kc * 8) = o;
  }
  __syncthreads();
}

template <int N>
__device__ __forceinline__ void rms_row_f32(const float* __restrict__ in, const float* __restrict__ gain, bf16_t* __restrict__ out, int lane) {
  constexpr int C = N / 256; float4 v[C]; float ss = 0.f;
#pragma unroll
  for (int i = 0; i < C; ++i) { v[i] = ((const float4*)in)[lane + 64 * i]; ss += v[i].x * v[i].x + v[i].y * v[i].y + v[i].z * v[i].z + v[i].w * v[i].w; }
  ss = wave_sum(ss); const float r = rsqrtf(ss * (1.f / N) + 1e-6f);
#pragma unroll
  for (int i = 0; i < C; ++i) {
    float4 g = ((const float4*)gain)[lane + 64 * i]; uint2 o;
    o.x = pack2(v[i].x * r * g.x, v[i].y * r * g.y); o.y = pack2(v[i].z * r * g.z, v[i].w * r * g.w);
    ((uint2*)out)[lane + 64 * i] = o;
  }
}
template <int N>
__device__ __forceinline__ void rms_row_bf16(const bf16_t* __restrict__ in, const float* __restrict__ gain, bf16_t* __restrict__ out, int lane) {
  constexpr int C = N / 256; uint2 v[C]; float ss = 0.f;
#pragma unroll
  for (int i = 0; i < C; ++i) { v[i] = ((const uint2*)in)[lane + 64 * i]; float a = bflo(v[i].x), b = bfhi(v[i].x), c = bflo(v[i].y), d = bfhi(v[i].y); ss += a * a + b * b + c * c + d * d; }
  ss = wave_sum(ss); const float r = rsqrtf(ss * (1.f / N) + 1e-6f);
#pragma unroll
  for (int i = 0; i < C; ++i) {
    float4 g = ((const float4*)gain)[lane + 64 * i]; uint2 o;
    o.x = pack2(bflo(v[i].x) * r * g.x, bfhi(v[i].x) * r * g.y); o.y = pack2(bflo(v[i].y) * r * g.z, bfhi(v[i].y) * r * g.w);
    ((uint2*)out)[lane + 64 * i] = o;
  }
}

#define GEMM_WAITV(n) asm volatile("s_waitcnt vmcnt(" #n ")" ::: "memory")
#define GEMM_RAWBAR() do { asm volatile("s_waitcnt lgkmcnt(0)" ::: "memory"); __builtin_amdgcn_s_barrier(); } while (0)
template <int BM, int NST, class Epi>
__device__ __forceinline__ void gemm_tile(const bf16_t* __restrict__ A, int lda, const bf16_t* __restrict__ B, int ldb, int K, int m0, int n0,
                                          unsigned char* smem, const Epi& epi) {
  constexpr int MI = BM / 32, NA = BM / 64, NV = NA + 2, D = NST - 1, STAGE_EL = (BM + 128) * 32;
  static_assert(NST == 3 || NST == 4, "ring depth");
  bf16_t* ring = (bf16_t*)smem;
  const int tid = opaque_tid(), lane = tid & 63, w = __builtin_amdgcn_readfirstlane(tid >> 6), wm = w >> 1, wn = w & 1;
  f32x4 acc[MI][4];
#pragma unroll
  for (int i = 0; i < MI; ++i)
#pragma unroll
    for (int j = 0; j < 4; ++j) acc[i][j] = (f32x4){0.f, 0.f, 0.f, 0.f};
  const int srow = tid >> 2, slc = (tid & 3) ^ ((tid >> 4) & 3);
  const bf16_t* Ag = A + (size_t)(m0 + srow) * lda + slc * 8;
  const bf16_t* Bg = B + (size_t)(n0 + srow) * ldb + slc * 8;
  const int nk = K >> 5;
#define GEMM_ISSUE(st, k0)                                                                                                     \
  do { bf16_t* sa_ = ring + (st) * STAGE_EL; bf16_t* sb_ = sa_ + BM * 32;                                                      \
    _Pragma("unroll") for (int i = 0; i < NA; ++i)                                                                             \
      __builtin_amdgcn_global_load_lds((const unsigned*)(Ag + (size_t)(64 * i) * lda + (k0)), (unsigned*)(sa_ + (i * 256 + w * 64) * 8), 16, 0, 0); \
    _Pragma("unroll") for (int i = 0; i < 2; ++i)                                                                              \
      __builtin_amdgcn_global_load_lds((const unsigned*)(Bg + (size_t)(64 * i) * ldb + (k0)), (unsigned*)(sb_ + (i * 256 + w * 64) * 8), 16, 0, 0); \
  } while (0)
  GEMM_ISSUE(0, 0);
  if (nk > 1) GEMM_ISSUE(1, 32);
  if (D >= 3 && nk > 2) GEMM_ISSUE(2, 64);
  const int fr = lane & 15, fq = lane >> 4;
  const int foff = fr * 32 + ((fq ^ ((fr >> 2) & 3)) * 8);
  int st = 0, stn = D % NST;
  for (int kt = 0; kt < nk; ++kt) {
    const int rem = min(D - 1, nk - 1 - kt);
    if (rem >= 2) { if (NV == 4) GEMM_WAITV(8); else GEMM_WAITV(12); }
    else if (rem == 1) { if (NV == 4) GEMM_WAITV(4); else GEMM_WAITV(6); }
    else GEMM_WAITV(0);
    GEMM_RAWBAR();
    const bf16_t* a_ = ring + st * STAGE_EL + (wm * (BM / 2)) * 32 + foff;
    const bf16_t* b_ = ring + st * STAGE_EL + BM * 32 + (wn * 64) * 32 + foff;
    bf16x8 af[MI], bfr[4];
#pragma unroll
    for (int j = 0; j < 4; ++j) bfr[j] = *(const bf16x8*)(b_ + j * 16 * 32);
#pragma unroll
    for (int i = 0; i < MI; ++i) af[i] = *(const bf16x8*)(a_ + i * 16 * 32);
    __builtin_amdgcn_sched_barrier(0);
    if (kt + D < nk) {
      bf16_t* sa_ = ring + stn * STAGE_EL; bf16_t* sb_ = sa_ + BM * 32; const int k0n = (kt + D) << 5;
#pragma unroll
      for (int i = 0; i < MI; ++i) {
#pragma unroll
        for (int j = 0; j < 4; ++j) acc[i][j] = MFMA16(af[i], bfr[j], acc[i][j]);
        if (i < NA) __builtin_amdgcn_global_load_lds((const unsigned*)(Ag + (size_t)(64 * i) * lda + k0n), (unsigned*)(sa_ + (i * 256 + w * 64) * 8), 16, 0, 0);
        else if (i < NV) __builtin_amdgcn_global_load_lds((const unsigned*)(Bg + (size_t)(64 * (i - NA)) * ldb + k0n), (unsigned*)(sb_ + ((i - NA) * 256 + w * 64) * 8), 16, 0, 0);
        __builtin_amdgcn_sched_barrier(0);
      }
    } else {
#pragma unroll
      for (int i = 0; i < MI; ++i)
#pragma unroll
        for (int j = 0; j < 4; ++j) acc[i][j] = MFMA16(af[i], bfr[j], acc[i][j]);
    }
    st = (st + 1 == NST) ? 0 : st + 1; stn = (stn + 1 == NST) ? 0 : stn + 1;
  }
  GEMM_RAWBAR();
#undef GEMM_ISSUE
  {
    float* stg = (float*)(smem + w * 18432);
    constexpr int SSTR = 68;
#pragma unroll
    for (int h = 0; h < MI / 4; ++h) {
#pragma unroll
      for (int i4 = 0; i4 < 4; ++i4)
#pragma unroll
        for (int j = 0; j < 4; ++j)
#pragma unroll
          for (int r = 0; r < 4; ++r) stg[(i4 * 16 + (lane >> 4) * 4 + r) * SSTR + j * 16 + (lane & 15)] = acc[h * 4 + i4][j][r];
      asm volatile("s_waitcnt lgkmcnt(0)" ::: "memory");
#pragma unroll
      for (int it = 0; it < 16; ++it) {
        const int rr = it * 4 + (lane >> 4);
        const float4 v = *(const float4*)(stg + rr * SSTR + (lane & 15) * 4);
        epi.store4(m0 + wm * (BM / 2) + h * 64 + rr, n0 + wn * 64 + (lane & 15) * 4, v);
      }
      asm volatile("s_waitcnt lgkmcnt(0)" ::: "memory");
    }
  }
  asm volatile("s_waitcnt vmcnt(0)" ::: "memory");
  GEMM_RAWBAR();
}

template <class F>
__device__ __forceinline__ void for_gemm_tiles(int MT, int NT, F f) {
  const int xcd = blockIdx.x & 7, local = blockIdx.x >> 3, nloc = gridDim.x >> 3;
  const int SM = (MT + 7) >> 3, SN = (NT + 7) >> 3, nsup = SM * SN, per_xcd = (nsup + 7) >> 3;
  for (int idx = local; idx < per_xcd * 64; idx += nloc) {
    const int st = (idx >> 6) * 8 + xcd; if (st >= nsup) continue;
    const int within = idx & 63; const int mt = (st / SN) * 8 + (within >> 3), nt = (st % SN) * 8 + (within & 7);
    if (mt < MT && nt < NT) f(mt, nt);
  }
}

struct EpiProj { bf16_t* proj; float* dtraw;
  __device__ __forceinline__ void store4(int r, int c, float4 v) const {
    if (c < PJW) { uint2 o; o.x = pack2(v.x, v.y); o.y = pack2(v.z, v.w); *(uint2*)(proj + (size_t)r * PJW + c) = o; }
    else *(float4*)(dtraw + r * 64 + c - PJW) = v; } };
struct EpiBf16 { bf16_t* o; int ld;
  __device__ __forceinline__ void store4(int r, int c, float4 v) const { uint2 t; t.x = pack2(v.x, v.y); t.y = pack2(v.z, v.w); *(uint2*)(o + (size_t)r * ld + c) = t; } };
struct EpiOut { const float* x; float* o;
  __device__ __forceinline__ void store4(int r, int c, float4 v) const { size_t i = (size_t)r * D_ + c; float4 xv = *(const float4*)(x + i); *(float4*)(o + i) = make_float4(xv.x + v.x, xv.y + v.y, xv.z + v.z, xv.w + v.w); } };
struct EpiF32 { float* o; int ld;
  __device__ __forceinline__ void store4(int r, int c, float4 v) const { *(float4*)(o + (size_t)r * ld + c) = v; } };

__device__ __forceinline__ void late_transposes(const Params& p, int first, int stride, unsigned char* smem) {
  unsigned char* ws = p.ws;
  for (int t = first; t < 3072; t += stride) {
    if (t < 2048) transpose_tile(p.w_out, 4096, 4096, (bf16_t*)(ws + OFF_WOUT), t, (float*)smem);
    else transpose_tile(p.w_query, 4096, 2048, (bf16_t*)(ws + OFF_WQ), t - 2048, (float*)smem);
  }
}

__device__ __forceinline__ void fp8_convert_tiles(const Params& p, int first, int stride) {
  unsigned char* ws = p.ws; const float* eu = p.expert_u; const float* ev = p.expert_v;
  for (int t = first; t < 8192; t += stride) {
    const int tid2 = opaque_tid(); const int row = t * 4 + (tid2 >> 6); const int tb = row >> 14, r = row & 16383;
    fp8_row((tb ? ev : eu) + (size_t)r * 4096, ws + (tb ? OFF_EV8 : OFF_EU8) + (size_t)r * 4096, (float*)(ws + OFF_ESC) + row, tid2 & 63);
  }
}

__device__ __forceinline__ void phase0(const Params& p, unsigned char* smem) {
  unsigned char* ws = p.ws;
  const int n0 = 3904, n1 = n0 + 384, n2 = n1 + 256, n3 = n2 + 2048, n4 = n3 + 1024, n5 = n4 + 64, n6 = n5 + 2048;
  if (gridDim.x != 512) fp8_convert_tiles(p, blockIdx.x, gridDim.x);
  const int tid = opaque_tid(), lane = tid & 63, w = tid >> 6;
  for (int t = blockIdx.x; t < n6; t += gridDim.x) {
    if (t < n0) transpose_tile(p.w_in, 4096, 7808, (bf16_t*)(ws + OFF_WIN), t, (float*)smem);
    else if (t < n1) transpose_tile(p.w_uq, 1024, 3072, (bf16_t*)(ws + OFF_WUQ), t - n0, (float*)smem);
    else if (t < n2) transpose_tile(p.w_ukv, 512, 4096, (bf16_t*)(ws + OFF_WUKV), t - n1, (float*)smem);
    else if (t < n4) { if (gridDim.x != 512) late_transposes(p, t - n2, 1 << 30, smem); }

    else if (t < n5) {
      const int base = (t - n4) * 4096; bf16_t* sk = (bf16_t*)(ws + OFF_SK);
#pragma unroll
      for (int i = 0; i < 4; ++i) { int e = base + (tid + 256 * i) * 4; float4 v = *(const float4*)(p.sub_keys + e); uint2 o; o.x = pack2(v.x, v.y); o.y = pack2(v.z, v.w); *(uint2*)(sk + e) = o; }
    } else {
      const int row = (t - n5) * 4 + w;
      rms_row_f32<4096>(p.x + (size_t)row * D_, p.norm_mix, (bf16_t*)(ws + OFF_A) + (size_t)row * D_, lane);
    }
  }
}

__device__ __forceinline__ void phase1(const Params& p, unsigned char* smem) {
  unsigned char* ws = p.ws;
  EpiProj epi{(bf16_t*)(ws + OFF_B), (float*)(ws + OFF_DTRAW)};
  const bf16_t* A = (const bf16_t*)(ws + OFF_A); const bf16_t* B = (const bf16_t*)(ws + OFF_WIN);
  for_gemm_tiles(T_ / GBM, 61, [&](int mt, int nt) { gemm_tile<GBM, GNST>(A, 4096, B, 4096, 4096, mt * GBM, nt * 128, smem, epi); });
  if (gridDim.x == 512 && (blockIdx.x & 7) == 7 && ((blockIdx.x >> 3) & 7) >= 5) {
    const int local = blockIdx.x >> 3; const int bi = (local >> 3) * 3 + ((local & 7) - 5);
    for (int t = bi; t < FP8_EARLY; t += 24) fp8_convert_tiles(p, t, 1 << 30);
  }
}

__device__ __forceinline__ void phase2(const Params& p, unsigned char* smem) {
  unsigned char* ws = p.ws;
  const int tid = opaque_tid(), lane = tid & 63, w = tid >> 6;
  const bf16_t* proj = (const bf16_t*)(ws + OFF_B);
  for (int t = blockIdx.x; t < 16; t += gridDim.x) {
    const int gid = t * 256 + tid; const int h = gid & 31, c = (gid >> 5) & 15, b = (gid >> 9) & 3, dir = gid >> 11;
    const float alf = p.a_log_f[h], alb = p.a_log_b[h], dbf = p.dt_bias_f[h], dbb = p.dt_bias_b[h];
    const float a = -expf(dir ? alb : alf); const float bias = dir ? dbb : dbf;
    const float* dtraw = (const float*)(ws + OFF_DTRAW) + dir * 32 + h; float* DT = (float*)(ws + OFF_DT) + (size_t)dir * T_ * 32 + h; float* AC = (float*)(ws + OFF_ACUM) + (size_t)dir * T_ * 32 + h;
    const int tbase = b * S_ + c * 128; const int l0 = dir ? 127 : 0, ls = dir ? -1 : 1;
    float cum = 0.f;
#pragma unroll 1
    for (int i0 = 0; i0 < 128; i0 += 16) {
      float raw[16];
#pragma unroll
      for (int j = 0; j < 16; ++j) raw[j] = dtraw[(tbase + l0 + ls * (i0 + j)) * 64];
#pragma unroll
      for (int j = 0; j < 16; ++j) {
        const int tt = tbase + l0 + ls * (i0 + j);
        const float r = raw[j] + bias; const float dt = fmaxf(r, 0.f) + log1pf(expf(-fabsf(r)));
        cum += dt * a; DT[tt * 32] = dt; AC[tt * 32] = cum;
      }
    }
  }
  for (int t = blockIdx.x; t < T_ / 4; t += gridDim.x) {
    const int row = t * 4 + w;
    rms_row_bf16<1024>(proj + (size_t)row * PJW, p.q_a_norm, (bf16_t*)(ws + OFF_CQN) + (size_t)row * 1024, lane);
    rms_row_bf16<512>(proj + (size_t)row * PJW + 1024, p.kv_a_norm, (bf16_t*)(ws + OFF_CKVN) + (size_t)row * 512, lane);
  }
  bf16_t* xc = (bf16_t*)(ws + OFF_A);
  for (int t = blockIdx.x; t < T_ / 4 * 2; t += gridDim.x) {
    const int idx = t * 256 + tid; const int tg = idx >> 9, c = (idx & 511) * 8; const int t0 = tg * 4; const int s0 = t0 & (S_ - 1);
    u32x4 rows[8];
#pragma unroll
    for (int j = 0; j < 8; ++j) {
      const int ss = s0 + j - 2;
      rows[j] = (ss >= 0 && ss < S_) ? *(const u32x4*)(proj + (size_t)(t0 + j - 2) * PJW + 3648 + c) : (u32x4){0u, 0u, 0u, 0u};
    }
    float wgt[5][8], bia[8];
#pragma unroll
    for (int wv = 0; wv < 5; ++wv) {
      const float4 w0 = *(const float4*)(p.conv_w + wv * 4096 + c), w1 = *(const float4*)(p.conv_w + wv * 4096 + c + 4);
      wgt[wv][0] = w0.x; wgt[wv][1] = w0.y; wgt[wv][2] = w0.z; wgt[wv][3] = w0.w; wgt[wv][4] = w1.x; wgt[wv][5] = w1.y; wgt[wv][6] = w1.z; wgt[wv][7] = w1.w;
    }
    { const float4 b0 = *(const float4*)(p.conv_b + c), b1 = *(const float4*)(p.conv_b + c + 4); bia[0] = b0.x; bia[1] = b0.y; bia[2] = b0.z; bia[3] = b0.w; bia[4] = b1.x; bia[5] = b1.y; bia[6] = b1.z; bia[7] = b1.w; }
#pragma unroll
    for (int o = 0; o < 4; ++o) {
      float acc[8];
#pragma unroll
      for (int e = 0; e < 8; ++e) acc[e] = bia[e];
#pragma unroll
      for (int wv = 0; wv < 5; ++wv) {
        const u32x4 v = rows[o + wv];
#pragma unroll
        for (int q = 0; q < 4; ++q) { acc[2 * q] += bflo(v[q]) * wgt[wv][2 * q]; acc[2 * q + 1] += bfhi(v[q]) * wgt[wv][2 * q + 1]; }
      }
#pragma unroll
      for (int e = 0; e < 8; ++e) acc[e] = acc[e] / (1.f + __expf(-acc[e]));
      u32x4 ov; ov[0] = pack2(acc[0], acc[1]); ov[1] = pack2(acc[2], acc[3]); ov[2] = pack2(acc[4], acc[5]); ov[3] = pack2(acc[6], acc[7]);
      *(u32x4*)(xc + (size_t)(t0 + o) * 4096 + c) = ov;
    }
  }
}

__device__ __forceinline__ void ssd_states_tile(const Params& p, int tile, unsigned char* smem) {
  unsigned char* ws = p.ws;
  const int g = tile & 7, c = (tile >> 3) & 15, b = tile >> 7; const int t0 = b * S_ + c * 128;
  const int tid = opaque_tid(), lane = tid & 63, w = tid >> 6;
  bf16_t* sBT = (bf16_t*)smem;
  bf16_t* sXT = sBT + 128 * 136;
  const bf16_t* xc = (const bf16_t*)(ws + OFF_A);
#pragma unroll
  for (int i = 0; i < 4; ++i) {
    const int item = tid + 256 * i; const int lp = item >> 4, nc = item & 15;
    uint4 v0 = *(const uint4*)(xc + (size_t)(t0 + 2 * lp) * 4096 + 2048 + g * 128 + nc * 8);
    uint4 v1 = *(const uint4*)(xc + (size_t)(t0 + 2 * lp + 1) * 4096 + 2048 + g * 128 + nc * 8);
    unsigned a0[4] = {v0.x, v0.y, v0.z, v0.w}, a1[4] = {v1.x, v1.y, v1.z, v1.w};
#pragma unroll
    for (int j = 0; j < 4; ++j) {
      *(unsigned*)(sBT + (nc * 8 + 2 * j) * 136 + 2 * lp) = (a0[j] & 0xffffu) | (a1[j] << 16);
      *(unsigned*)(sBT + (nc * 8 + 2 * j + 1) * 136 + 2 * lp) = (a0[j] >> 16) | (a1[j] & 0xffff0000u);
    }
  }
#pragma unroll 1
  for (int dr = 0; dr < 8; ++dr) {
    const int dir = dr >> 2, r = dr & 3, hd = g * 4 + r;
    const float* DT = (const float*)(ws + OFF_DT) + (size_t)dir * T_ * 32; const float* AC = (const float*)(ws + OFF_ACUM) + (size_t)dir * T_ * 32;
    const float aend = AC[(t0 + (dir ? 0 : 127)) * 32 + hd];
#pragma unroll
    for (int i = 0; i < 2; ++i) {
      const int item = tid + 256 * i; const int lp = item >> 3, pc = item & 7;
      const int l0 = 2 * lp, l1 = 2 * lp + 1;
      const float w0 = DT[(t0 + l0) * 32 + hd] * expf(aend - AC[(t0 + l0) * 32 + hd]);
      const float w1 = DT[(t0 + l1) * 32 + hd] * expf(aend - AC[(t0 + l1) * 32 + hd]);
      uint4 v0 = *(const uint4*)(xc + (size_t)(t0 + l0) * 4096 + hd * 64 + pc * 8);
      uint4 v1 = *(const uint4*)(xc + (size_t)(t0 + l1) * 4096 + hd * 64 + pc * 8);
      unsigned a0[4] = {v0.x, v0.y, v0.z, v0.w}, a1[4] = {v1.x, v1.y, v1.z, v1.w};
#pragma unroll
      for (int j = 0; j < 4; ++j) {
        *(unsigned*)(sXT + (pc * 8 + 2 * j) * 136 + l0) = pack2(bflo(a0[j]) * w0, bflo(a1[j]) * w1);
        *(unsigned*)(sXT + (pc * 8 + 2 * j + 1) * 136 + l0) = pack2(bfhi(a0[j]) * w0, bfhi(a1[j]) * w1);
      }
    }
    __syncthreads();
    f32x4 acc[8];
#pragma unroll
    for (int j = 0; j < 8; ++j) acc[j] = (f32x4){0.f, 0.f, 0.f, 0.f};
#pragma unroll
    for (int ks = 0; ks < 4; ++ks) {
      bf16x8 af = *(const bf16x8*)(sXT + (16 * w + (lane & 15)) * 136 + ks * 32 + (lane >> 4) * 8);
#pragma unroll
      for (int j = 0; j < 8; ++j) {
        bf16x8 bfr = *(const bf16x8*)(sBT + (j * 16 + (lane & 15)) * 136 + ks * 32 + (lane >> 4) * 8);
        acc[j] = MFMA16(af, bfr, acc[j]);
      }
    }
    bf16_t* st = (bf16_t*)(ws + OFF_ST) + ((((size_t)(dir * 4 + b) * 16 + c) * 32 + hd) * 64) * 128;
    bf16_t* stg = sXT + 64 * 136 + w * (16 * 136);
#pragma unroll
    for (int j = 0; j < 8; ++j)
#pragma unroll
      for (int rr = 0; rr < 4; ++rr) stg[((lane >> 4) * 4 + rr) * 136 + j * 16 + (lane & 15)] = f2bf(acc[j][rr]);
    asm volatile("s_waitcnt lgkmcnt(0)" ::: "memory");
#pragma unroll
    for (int q = 0; q < 4; ++q) {
      const int cc = lane + 64 * q; const int row = cc >> 4, ch = cc & 15;
      *(u32x4*)(st + (16 * w + row) * 128 + ch * 8) = *(const u32x4*)(stg + row * 136 + ch * 8);
    }
    __syncthreads();
  }
}

__device__ __forceinline__ void phase3(const Params& p, unsigned char* smem) {
  unsigned char* ws = p.ws;
  { EpiBf16 epi{(bf16_t*)(ws + OFF_QRAW), 3072};
    const bf16_t* A = (const bf16_t*)(ws + OFF_CQN); const bf16_t* B = (const bf16_t*)(ws + OFF_WUQ);
    for_gemm_tiles(T_ / GBM, 24, [&](int mt, int nt) { gemm_tile<GBM, GNST>(A, 1024, B, 1024, 1024, mt * GBM, nt * 128, smem, epi); }); }
  { EpiBf16 epi{(bf16_t*)(ws + OFF_KVRAW), 4096};
    const bf16_t* A = (const bf16_t*)(ws + OFF_CKVN); const bf16_t* B = (const bf16_t*)(ws + OFF_WUKV);
    for_gemm_tiles(T_ / GBM, 32, [&](int mt, int nt) { gemm_tile<GBM, GNST>(A, 512, B, 512, 512, mt * GBM, nt * 128, smem, epi); }); }
  if (gridDim.x == 512 && (blockIdx.x & 7) >= 4) late_transposes(p, (blockIdx.x >> 3) * 4 + ((blockIdx.x & 7) - 4), 256, smem);
  for (int t = blockIdx.x; t < 512; t += gridDim.x) ssd_states_tile(p, t, smem);
}

__device__ __forceinline__ void phase4(const Params& p, unsigned char* smem) {
  unsigned char* ws = p.ws;
  const int tid = opaque_tid(), lane = tid & 63, w = tid >> 6;
  for (int t = blockIdx.x; t < 1024; t += gridDim.x) {
    const int gid = t * 256 + tid; const int nch = gid & 15, pp = (gid >> 4) & 63, h = (gid >> 10) & 31, b = (gid >> 15) & 3, dir = gid >> 17;
    const float* AC = (const float*)(ws + OFF_ACUM) + (size_t)dir * T_ * 32;
    bf16_t* base = (bf16_t*)(ws + OFF_ST) + ((((size_t)(dir * 4 + b) * 16) * 32 + h) * 64 + pp) * 128 + nch * 8;
    u32x4 sv[16]; float dec[16];
#pragma unroll
    for (int i = 0; i < 16; ++i) {
      const int c = dir ? 15 - i : i;
      sv[i] = *(const u32x4*)(base + (size_t)c * (32 * 64 * 128));
      dec[i] = AC[(b * S_ + c * 128 + (dir ? 0 : 127)) * 32 + h];
    }
    float hs[8];
#pragma unroll
    for (int j = 0; j < 8; ++j) hs[j] = 0.f;
#pragma unroll
    for (int i = 0; i < 16; ++i) {
      const int c = dir ? 15 - i : i;
      u32x4 o; o[0] = pack2(hs[0], hs[1]); o[1] = pack2(hs[2], hs[3]); o[2] = pack2(hs[4], hs[5]); o[3] = pack2(hs[6], hs[7]);
      *(u32x4*)(base + (size_t)c * (32 * 64 * 128)) = o;
      const float d = expf(dec[i]);
#pragma unroll
      for (int q = 0; q < 4; ++q) { hs[2 * q] = hs[2 * q] * d + bflo(sv[i][q]); hs[2 * q + 1] = hs[2 * q + 1] * d + bfhi(sv[i][q]); }
    }
  }
  const bf16_t* proj = (const bf16_t*)(ws + OFF_B);
  const bf16_t* qraw = (const bf16_t*)(ws + OFF_QRAW); const bf16_t* kvraw = (const bf16_t*)(ws + OFF_KVRAW);
  const float qscale = 0.07216878364870322f * 1.4426950408889634f;
  const float* const qn_ = p.q_norm; const float* const kn_ = p.k_norm; const int* const pos_ = p.pos;
  const float gq0 = qn_[lane], gq1 = qn_[lane + 64], gq2 = qn_[lane + 128], gk0 = kn_[lane], gk1 = kn_[lane + 64], gk2 = kn_[lane + 128];
  const float invf = exp2f(-(float)(lane & 31) * (13.287712379549449f / 32.f));
  for (int tt = blockIdx.x * 4 + w; tt < T_; tt += gridDim.x * 4) {
    const float posf = (float)pos_[tt];
    float sn, cs; sincosf(posf * invf, &sn, &cs);
    const int b = tt >> 11, sq = tt & (S_ - 1);
    const float kr = bf2f(proj[(size_t)tt * PJW + 1536 + lane]);
    float x0[4], x1[4], x2[4], n0[4], n1[4], n2[4];
#define QK_LOAD(HQ, X0, X1, X2) do { const int wh_ = (HQ) >> 2, hh_ = ((HQ) & 3) * 4;                                       \
      _Pragma("unroll") for (int j = 0; j < 4; ++j) {                                                                       \
        const bf16_t* sp = wh_ ? (kvraw + (size_t)tt * 4096 + (hh_ + j) * 256) : (qraw + (size_t)tt * 3072 + (hh_ + j) * 192); \
        X0[j] = bf2f(sp[lane]); X1[j] = bf2f(sp[lane + 64]); X2[j] = wh_ ? kr : bf2f(sp[lane + 128]); } } while (0)
#define QK_PROC(HQ, X0, X1, X2) do { const int which = (HQ) >> 2, h0 = ((HQ) & 3) * 4;                                      \
      const float g0 = which ? gk0 : gq0, g1 = which ? gk1 : gq1, g2 = which ? gk2 : gq2;                                  \
      const float scl = which ? 1.f : qscale;                                                                               \
      bf16_t* dbase = (bf16_t*)(ws + (which == 0 ? OFF_Q : OFF_K)) + ((size_t)(b * 16 + h0) * S_ + sq) * 192;              \
      _Pragma("unroll") for (int j = 0; j < 4; ++j) {                                                                       \
        const float ss = wave_sum_fast(X0[j] * X0[j] + X1[j] * X1[j] + X2[j] * X2[j]);                                      \
        const float r = rsqrtf(ss * (1.f / 192.f) + 1e-6f);                                                                 \
        const float y0 = X0[j] * r * g0, y1 = X1[j] * r * g1, y2 = X2[j] * r * g2;                                          \
        const float other = __shfl_xor(y2, 32);                                                                             \
        const float yr = (lane < 32) ? (y2 * cs - other * sn) : (other * sn + y2 * cs);                                     \
        bf16_t* dst = dbase + (size_t)j * S_ * 192;                                                                         \
        dst[lane] = f2bf(y0 * scl); dst[lane + 64] = f2bf(y1 * scl); dst[lane + 128] = f2bf(yr * scl); } } while (0)
    QK_LOAD(0, x0, x1, x2);
#pragma unroll 1
    for (int hq = 0; hq < 8; hq += 2) {
      QK_LOAD(hq + 1, n0, n1, n2);
      QK_PROC(hq, x0, x1, x2);
      if (hq + 2 < 8) QK_LOAD(hq + 2, x0, x1, x2);
      QK_PROC(hq + 1, n0, n1, n2);
    }
#undef QK_LOAD
#undef QK_PROC
  }
  bf16_t* sm = (bf16_t*)smem;
  for (int t = blockIdx.x; t < 2048; t += gridDim.x) {
    const int sb = t & 31, head = (t >> 5) & 15, b = t >> 9; const int tbase = b * S_ + sb * 64;
    __syncthreads();
#pragma unroll
    for (int i = 0; i < 4; ++i) {
      const int cidx = tid + 256 * i; const int srow = cidx >> 4, dc = cidx & 15;
      uint4 v = *(const uint4*)(kvraw + (size_t)(tbase + srow) * 4096 + head * 256 + 128 + dc * 8);
      unsigned a[4] = {v.x, v.y, v.z, v.w};
#pragma unroll
      for (int j = 0; j < 4; ++j) { sm[(dc * 8 + 2 * j) * 72 + srow] = (bf16_t)(a[j] & 0xffffu); sm[(dc * 8 + 2 * j + 1) * 72 + srow] = (bf16_t)(a[j] >> 16); }
    }
    __syncthreads();
    bf16_t* vt = (bf16_t*)(ws + OFF_VT) + (size_t)(b * 16 + head) * 128 * S_ + sb * 64;
#pragma unroll
    for (int i = 0; i < 4; ++i) {
      const int cidx = tid + 256 * i; const int d = cidx >> 3, sc8 = cidx & 7;
      *(uint4*)(vt + (size_t)d * S_ + sc8 * 8) = *(const uint4*)(sm + d * 72 + sc8 * 8);
    }
  }
}

__device__ __forceinline__ void attn_tile(const Params& p, int tile, unsigned char* smem) {
  unsigned char* ws = p.ws;
  const int qb = tile & 15, head = (tile >> 4) & 15, b = tile >> 8;
  const int tid = opaque_tid(), lane = tid & 63, w = tid >> 6, lr = lane & 31, lh = lane >> 5;
  bf16_t* sK = (bf16_t*)smem;
  bf16_t* sV = sK + 64 * 200;
  const bf16_t* Qp = (const bf16_t*)(ws + OFF_Q) + ((size_t)(b * 16 + head) * S_ + qb * 128 + w * 32) * 192;
  const bf16_t* Kp = (const bf16_t*)(ws + OFF_K) + (size_t)(b * 16 + head) * S_ * 192;
  const bf16_t* Vp = (const bf16_t*)(ws + OFF_VT) + (size_t)(b * 16 + head) * 128 * S_;
  bf16x8 qf[12];
#pragma unroll
  for (int ks = 0; ks < 12; ++ks) qf[ks] = *(const bf16x8*)(Qp + lr * 192 + ks * 16 + lh * 8);
  f32x16 o[4];
#pragma unroll
  for (int d = 0; d < 4; ++d)
#pragma unroll
    for (int r = 0; r < 16; ++r) o[d][r] = 0.f;
  float m = -INFINITY, lsum = 0.f;
  u32x4 rk[6], rv[4];
  int koff[6];
#pragma unroll
  for (int i = 0; i < 6; ++i) { const int cidx = tid + 256 * i; const int row = cidx / 24; koff[i] = row * 200 + (cidx - row * 24) * 8; }
  const int vrow_ = tid >> 3, vkc = (tid & 7) * 8;
  const int vpos = (vkc & ~15) + ((vkc & 8) ? 4 : 0);
#pragma unroll
  for (int i = 0; i < 6; ++i) rk[i] = *(const u32x4*)(Kp + (size_t)(tid + 256 * i) * 8);
#pragma unroll
  for (int i = 0; i < 4; ++i) rv[i] = *(const u32x4*)(Vp + (size_t)(vrow_ + 32 * i) * S_ + vkc);
#pragma unroll 1
  for (int kt = 0; kt < 32; ++kt) {
    __syncthreads();
#pragma unroll
    for (int i = 0; i < 6; ++i) *(u32x4*)(sK + koff[i]) = rk[i];
#pragma unroll
    for (int i = 0; i < 4; ++i) { bf16_t* d = sV + (vrow_ + 32 * i) * 72 + vpos; *(u32x2*)d = (u32x2){rv[i][0], rv[i][1]}; *(u32x2*)(d + 8) = (u32x2){rv[i][2], rv[i][3]}; }
    __syncthreads();
    if (kt + 1 < 32) {
      const int key0 = (kt + 1) * 64;
#pragma unroll
      for (int i = 0; i < 6; ++i) rk[i] = *(const u32x4*)(Kp + (size_t)key0 * 192 + (size_t)(tid + 256 * i) * 8);
#pragma unroll
      for (int i = 0; i < 4; ++i) rv[i] = *(const u32x4*)(Vp + (size_t)(vrow_ + 32 * i) * S_ + key0 + vkc);
    }
    f32x16 s0, s1;
#pragma unroll
    for (int r = 0; r < 16; ++r) { s0[r] = 0.f; s1[r] = 0.f; }
    const bf16_t* kb0 = sK + lr * 200 + lh * 8; const bf16_t* kb1 = kb0 + 32 * 200;
#pragma unroll
    for (int ks = 0; ks < 12; ++ks) { const bf16x8 kf = *(const bf16x8*)(kb0 + ks * 16); s0 = MFMA32(kf, qf[ks], s0); }
    {
      float mx = fmaxf(fmaxf(s0[0], s0[1]), fmaxf(s0[2], s0[3]));
#pragma unroll
      for (int r = 4; r < 16; ++r) mx = fmaxf(mx, s0[r]);
      mx = fmaxf(mx, __shfl_xor(mx, 32));
      const float mn = fmaxf(m, mx);
      if (__builtin_amdgcn_ballot_w64(mn > m) != 0) {
        const float alpha = __builtin_amdgcn_exp2f(m - mn); lsum *= alpha;
#pragma unroll
        for (int d = 0; d < 4; ++d)
#pragma unroll
          for (int r = 0; r < 16; ++r) o[d][r] *= alpha;
      }
      m = mn;
    }
#pragma unroll
    for (int ks = 0; ks < 12; ++ks) { const bf16x8 kf = *(const bf16x8*)(kb1 + ks * 16); s1 = MFMA32(kf, qf[ks], s1); }
    float psA = 0.f;
#pragma unroll
    for (int r = 0; r < 16; ++r) { const float e = __builtin_amdgcn_exp2f(s0[r] - m); s0[r] = e; psA += e; }
    {
      float mx = fmaxf(fmaxf(s1[0], s1[1]), fmaxf(s1[2], s1[3]));
#pragma unroll
      for (int r = 4; r < 16; ++r) mx = fmaxf(mx, s1[r]);
      mx = fmaxf(mx, __shfl_xor(mx, 32));
      const float mn = fmaxf(m, mx);
      if (__builtin_amdgcn_ballot_w64(mn > m) != 0) {
        const float alpha = __builtin_amdgcn_exp2f(m - mn); lsum *= alpha; psA *= alpha;
#pragma unroll
        for (int r = 0; r < 16; ++r) s0[r] *= alpha;
#pragma unroll
        for (int d = 0; d < 4; ++d)
#pragma unroll
          for (int r = 0; r < 16; ++r) o[d][r] *= alpha;
      }
      m = mn;
    }
    lsum += psA;
    const bf16_t* vb = sV + lr * 72 + lh * 8;
#pragma unroll
    for (int sh = 0; sh < 2; ++sh) {
      const bf16x8 pf = pack8(s0[8 * sh + 0], s0[8 * sh + 1], s0[8 * sh + 2], s0[8 * sh + 3], s0[8 * sh + 4], s0[8 * sh + 5], s0[8 * sh + 6], s0[8 * sh + 7]);
#pragma unroll
      for (int d = 0; d < 4; ++d) { const bf16x8 af = *(const bf16x8*)(vb + d * 32 * 72 + sh * 16); o[d] = MFMA32(af, pf, o[d]); }
    }
    float psB = 0.f;
#pragma unroll
    for (int r = 0; r < 16; ++r) { const float e = __builtin_amdgcn_exp2f(s1[r] - m); s1[r] = e; psB += e; }
    lsum += psB;
#pragma unroll
    for (int sh = 0; sh < 2; ++sh) {
      const bf16x8 pf = pack8(s1[8 * sh + 0], s1[8 * sh + 1], s1[8 * sh + 2], s1[8 * sh + 3], s1[8 * sh + 4], s1[8 * sh + 5], s1[8 * sh + 6], s1[8 * sh + 7]);
#pragma unroll
      for (int d = 0; d < 4; ++d) { const bf16x8 af = *(const bf16x8*)(vb + d * 32 * 72 + 32 + sh * 16); o[d] = MFMA32(af, pf, o[d]); }
    }
  }
  const float lt = lsum + __shfl_xor(lsum, 32); const float inv = 1.f / lt;
  float ss = 0.f;
#pragma unroll
  for (int d = 0; d < 4; ++d)
#pragma unroll
    for (int r = 0; r < 16; ++r) { o[d][r] *= inv; ss += o[d][r] * o[d][r]; }
  ss += __shfl_xor(ss, 32);
  const float rstd = rsqrtf(ss * (1.f / 128.f) + 1e-6f);
  const int tt = b * S_ + qb * 128 + w * 32 + lr;
  bf16_t* mix = (bf16_t*)(ws + OFF_MIX) + (size_t)tt * 4096 + head * 128;
  const float* gn = p.attn_out_norm + head * 128;
#pragma unroll
  for (int d = 0; d < 4; ++d)
#pragma unroll
    for (int rg = 0; rg < 4; ++rg) {
      const int dd = d * 32 + 8 * rg + 4 * lh;
      float4 g = *(const float4*)(gn + dd); uint2 ov;
      ov.x = pack2(o[d][4 * rg + 0] * rstd * g.x, o[d][4 * rg + 1] * rstd * g.y); ov.y = pack2(o[d][4 * rg + 2] * rstd * g.z, o[d][4 * rg + 3] * rstd * g.w);
      *(uint2*)(mix + dd) = ov;
    }
}

__device__ __forceinline__ void ssd_out_tile(const Params& p, int tile, unsigned char* smem) {
  unsigned char* ws = p.ws;
  const int g = tile & 7, c = (tile >> 3) & 15, b = tile >> 7; const int t0 = b * S_ + c * 128;
  const int tid = opaque_tid(), lane = tid & 63, w = tid >> 6, lr = lane & 31, lh = lane >> 5;
  bf16_t* sC = (bf16_t*)smem;
  bf16_t* sB = sC + 128 * 136;
  bf16_t* sXT = sB;
  float* sAc = (float*)(sB + 64 * 132);
  float* sDt = sAc + 128;
  bf16_t* sH = (bf16_t*)(sDt + 128);
  const bf16_t* xc = (const bf16_t*)(ws + OFF_A);
  const bf16_t* proj = (const bf16_t*)(ws + OFF_B);
  __syncthreads();
#pragma unroll
  for (int i = 0; i < 8; ++i) {
    const int cidx = tid + 256 * i; const int row = cidx >> 4, nc = cidx & 15;
    *(uint4*)(sB + row * 136 + nc * 8) = *(const uint4*)(xc + (size_t)(t0 + row) * 4096 + 2048 + g * 128 + nc * 8);
    *(uint4*)(sC + row * 136 + nc * 8) = *(const uint4*)(xc + (size_t)(t0 + row) * 4096 + 3072 + g * 128 + nc * 8);
  }
  __syncthreads();
  const int l0 = 32 * w, lidx = l0 + lr;
  bf16x8 cfr[8];
#pragma unroll
  for (int ks = 0; ks < 8; ++ks) cfr[ks] = *(const bf16x8*)(sC + lidx * 136 + ks * 16 + lh * 8);
  f32x16 G[4];
#pragma unroll
  for (int st = 0; st < 4; ++st) {
#pragma unroll
    for (int r = 0; r < 16; ++r) G[st][r] = 0.f;
#pragma unroll
    for (int ks = 0; ks < 8; ++ks) {
      bf16x8 af = *(const bf16x8*)(sB + (st * 32 + lr) * 136 + ks * 16 + lh * 8);
      G[st] = MFMA32(af, cfr[ks], G[st]);
    }
  }
  const int tt = t0 + lidx;
  bf16_t* mixrow = (bf16_t*)(ws + OFF_MIX) + (size_t)tt * 4096 + 2048 + g * 256;
  float ssq = 0.f;
#pragma unroll 1
  for (int r = 0; r < 4; ++r) {
    const int hd = g * 4 + r;
    __syncthreads();
#pragma unroll
    for (int i = 0; i < 2; ++i) {
      const int item = tid + 256 * i; const int sp = item >> 3, pc = item & 7;
      uint4 v0 = *(const uint4*)(xc + (size_t)(t0 + 2 * sp) * 4096 + hd * 64 + pc * 8);
      uint4 v1 = *(const uint4*)(xc + (size_t)(t0 + 2 * sp + 1) * 4096 + hd * 64 + pc * 8);
      unsigned a0[4] = {v0.x, v0.y, v0.z, v0.w}, a1[4] = {v1.x, v1.y, v1.z, v1.w};
#pragma unroll
      for (int j = 0; j < 4; ++j) {
        *(unsigned*)(sXT + (pc * 8 + 2 * j) * 132 + 2 * sp) = (a0[j] & 0xffffu) | (a1[j] << 16);
        *(unsigned*)(sXT + (pc * 8 + 2 * j + 1) * 132 + 2 * sp) = (a0[j] >> 16) | (a1[j] & 0xffff0000u);
      }
    }
    f32x16 y[2];
#pragma unroll
    for (int pt = 0; pt < 2; ++pt)
#pragma unroll
      for (int rr = 0; rr < 16; ++rr) y[pt][rr] = 0.f;
#pragma unroll 1
    for (int dir = 0; dir < 2; ++dir) {
      const float* DT = (const float*)(ws + OFF_DT) + (size_t)dir * T_ * 32; const float* AC = (const float*)(ws + OFF_ACUM) + (size_t)dir * T_ * 32;
      const bf16_t* hin = (const bf16_t*)(ws + OFF_ST) + ((((size_t)(dir * 4 + b) * 16 + c) * 32 + hd) * 64) * 128;
      u32x4 hreg[4];
#pragma unroll
      for (int q = 0; q < 4; ++q) { const int cc = tid + 256 * q; hreg[q] = *(const u32x4*)(hin + (cc >> 4) * 128 + (cc & 15) * 8); }
      __syncthreads();
      if (tid < 128) { sAc[tid] = AC[(t0 + tid) * 32 + hd]; sDt[tid] = DT[(t0 + tid) * 32 + hd]; }
#pragma unroll
      for (int q = 0; q < 4; ++q) { const int cc = tid + 256 * q; *(u32x4*)(sH + (cc >> 4) * 136 + (cc & 15) * 8) = hreg[q]; }
      __syncthreads();
      const float acl = sAc[lidx];
      const int sgn = 1 - 2 * dir;
#pragma unroll
      for (int st = 0; st < 4; ++st)
#pragma unroll
        for (int sh = 0; sh < 2; ++sh) {
          const int sb0 = st * 32 + sh * 16 + lh * 4;
          float4 a0 = *(const float4*)(sAc + sb0), a1 = *(const float4*)(sAc + sb0 + 8);
          float4 d0 = *(const float4*)(sDt + sb0), d1 = *(const float4*)(sDt + sb0 + 8);
          float av[8] = {a0.x, a0.y, a0.z, a0.w, a1.x, a1.y, a1.z, a1.w};
          float dv[8] = {d0.x, d0.y, d0.z, d0.w, d1.x, d1.y, d1.z, d1.w};
          float mv[8];
#pragma unroll
          for (int j = 0; j < 8; ++j) {
            const int sidx = sb0 + (j & 3) + 8 * (j >> 2);
            const float ex = ((lidx - sidx) * sgn >= 0) ? (acl - av[j]) : -INFINITY;
            mv[j] = G[st][8 * sh + j] * (__expf(ex) * dv[j]);
          }
          bf16x8 mf = pack8(mv[0], mv[1], mv[2], mv[3], mv[4], mv[5], mv[6], mv[7]);
#pragma unroll
          for (int pt = 0; pt < 2; ++pt) {
            const bf16_t* xrow = sXT + (pt * 32 + lr) * 132 + sb0;
            bf16x8 af = mk8(*(const uint2*)xrow, *(const uint2*)(xrow + 8));
            y[pt] = MFMA32(af, mf, y[pt]);
          }
        }
      f32x16 yo[2];
#pragma unroll
      for (int pt = 0; pt < 2; ++pt)
#pragma unroll
        for (int rr = 0; rr < 16; ++rr) yo[pt][rr] = 0.f;
#pragma unroll
      for (int ks = 0; ks < 8; ++ks)
#pragma unroll
        for (int pt = 0; pt < 2; ++pt) {
          bf16x8 hf = *(const bf16x8*)(sH + (pt * 32 + lr) * 136 + ks * 16 + lh * 8);
          yo[pt] = MFMA32(hf, cfr[ks], yo[pt]);
        }
      const float el = expf(acl);
#pragma unroll
      for (int pt = 0; pt < 2; ++pt)
#pragma unroll
        for (int rr = 0; rr < 16; ++rr) y[pt][rr] += el * yo[pt][rr];
    }
    const float dsk = p.d_skip[hd];
#pragma unroll
    for (int pt = 0; pt < 2; ++pt)
#pragma unroll
      for (int rg = 0; rg < 4; ++rg) {
        const int pp = pt * 32 + 8 * rg + 4 * lh; const int ch = hd * 64 + pp;
        uint2 xv = *(const uint2*)(xc + (size_t)tt * 4096 + ch);
        uint2 zv = *(const uint2*)(proj + (size_t)tt * PJW + 1600 + ch);
        float xs4[4] = {bflo(xv.x), bfhi(xv.x), bflo(xv.y), bfhi(xv.y)};
        float zs4[4] = {bflo(zv.x), bfhi(zv.x), bflo(zv.y), bfhi(zv.y)};
        float yv[4];
#pragma unroll
        for (int j = 0; j < 4; ++j) { float v = y[pt][4 * rg + j] + dsk * xs4[j]; v *= zs4[j] / (1.f + __expf(-zs4[j])); yv[j] = v; ssq += v * v; }
        uint2 ov; ov.x = pack2(yv[0], yv[1]); ov.y = pack2(yv[2], yv[3]);
        *(uint2*)(mixrow + r * 64 + pp) = ov;
      }
  }
  ssq += __shfl_xor(ssq, 32);
  const float rstd = rsqrtf(ssq * (1.f / 256.f) + 1e-6f);
  __threadfence_block();
#pragma unroll
  for (int r = 0; r < 4; ++r)
#pragma unroll
    for (int pt = 0; pt < 2; ++pt)
#pragma unroll
      for (int rg = 0; rg < 4; ++rg) {
        const int pp = pt * 32 + 8 * rg + 4 * lh;
        uint2 v = *(uint2*)(mixrow + r * 64 + pp);
        float4 gn = *(const float4*)(p.ssm_out_norm + g * 256 + r * 64 + pp);
        uint2 ov; ov.x = pack2(bflo(v.x) * rstd * gn.x, bfhi(v.x) * rstd * gn.y); ov.y = pack2(bflo(v.y) * rstd * gn.z, bfhi(v.y) * rstd * gn.w);
        *(uint2*)(mixrow + r * 64 + pp) = ov;
      }
}

__device__ __forceinline__ void phase5(const Params& p, unsigned char* smem) {
  const int xcd = blockIdx.x & 7, local = blockIdx.x >> 3, nloc = gridDim.x >> 3;
  if (gridDim.x == 512) {
    const int conv_step = (local >= 32) ? 1 : 0;
#pragma unroll 1
    for (int step = 0; step < 3; ++step) {
      if (step == conv_step) fp8_convert_tiles(p, FP8_EARLY + blockIdx.x, 512);
      else {
        const int idx = local + 64 * ((step > conv_step) ? step - 1 : step);
        attn_tile(p, ((idx >> 6) * 8 + xcd) * 64 + (idx & 63), smem);
      }
    }
  } else {
    for (int idx = local; idx < 128; idx += nloc) attn_tile(p, ((idx >> 6) * 8 + xcd) * 64 + (idx & 63), smem);
  }
  for (int t = blockIdx.x; t < 512; t += gridDim.x) ssd_out_tile(p, t, smem);
}

__device__ __forceinline__ void phase6(const Params& p, unsigned char* smem) {
  unsigned char* ws = p.ws;
  EpiOut epi{p.x, p.out};
  const bf16_t* A = (const bf16_t*)(ws + OFF_MIX); const bf16_t* B = (const bf16_t*)(ws + OFF_WOUT);
  for_gemm_tiles(T_ / GBM, 32, [&](int mt, int nt) { gemm_tile<GBM, GNST>(A, 4096, B, 4096, 4096, mt * GBM, nt * 128, smem, epi); });
}

__device__ __forceinline__ void phase7(const Params& p, unsigned char* smem) {
  unsigned char* ws = p.ws; const int tid = opaque_tid(); const int lane = tid & 63, w = tid >> 6;
  for (int t = blockIdx.x; t < T_ / 4; t += gridDim.x) {
    const int row = t * 4 + w;
    rms_row_f32<4096>(p.out + (size_t)row * D_, p.norm_ffn, (bf16_t*)(ws + OFF_A) + (size_t)row * D_, lane);
  }
}

__device__ __forceinline__ void phase8(const Params& p, unsigned char* smem) {
  unsigned char* ws = p.ws;
  EpiBf16 epi{(bf16_t*)(ws + OFF_QP), 2048};
  const bf16_t* A = (const bf16_t*)(ws + OFF_A); const bf16_t* B = (const bf16_t*)(ws + OFF_WQ);
  for_gemm_tiles(T_ / GBM, 16, [&](int mt, int nt) { gemm_tile<GBM, GNST>(A, 4096, B, 4096, 4096, mt * GBM, nt * 128, smem, epi); });
}

__device__ __forceinline__ void phase9(const Params& p, unsigned char* smem) {
  unsigned char* ws = p.ws;
  EpiF32 epi{(float*)(ws + OFF_SC), 2048};
  const bf16_t* A = (const bf16_t*)(ws + OFF_QP); const bf16_t* B = (const bf16_t*)(ws + OFF_SK);
  for (int t = blockIdx.x; t < 1024; t += gridDim.x) {
    const int blk = t & 15, mt = t >> 4;
    gemm_tile<128, 4>(A + blk * 128, 2048, B, 128, 128, mt * 128, blk * 128, smem, epi);
  }
}

#define WAVE_LDS_FENCE() asm volatile("s_waitcnt lgkmcnt(0)" ::: "memory")
#define WAVE_LDS_FENCE() asm volatile("s_waitcnt lgkmcnt(0)" ::: "memory")
__device__ __forceinline__ void topk16_rank(const float a, const float b, int lane, unsigned* skey, float* tv, int* ti) {
  const unsigned ka = (fkey(a) & ~127u) | (unsigned)(127 - lane), kb = (fkey(b) & ~127u) | (unsigned)(63 - lane);
  unsigned T = 0u;
#pragma unroll
  for (int bit = 31; bit >= 0; --bit) {
    const unsigned c = T | (1u << bit);
    const int cnt = __builtin_popcountll(__builtin_amdgcn_ballot_w64(ka >= c)) + __builtin_popcountll(__builtin_amdgcn_ballot_w64(kb >= c));
    T = (cnt >= 16) ? c : T;
  }
  const bool sa = ka >= T, sb = kb >= T;
  const unsigned long long ma = __builtin_amdgcn_ballot_w64(sa), mb = __builtin_amdgcn_ballot_w64(sb);
  const int pa = (int)__builtin_amdgcn_mbcnt_hi((unsigned)(ma >> 32), __builtin_amdgcn_mbcnt_lo((unsigned)ma, 0u));
  const int pb = __builtin_popcountll(ma) + (int)__builtin_amdgcn_mbcnt_hi((unsigned)(mb >> 32), __builtin_amdgcn_mbcnt_lo((unsigned)mb, 0u));
  float* sval = (float*)(skey + 16); int* sidx = (int*)(skey + 32);
  if (sa) { skey[pa & 15] = ka; sval[pa & 15] = a; sidx[pa & 15] = lane; }
  if (sb) { skey[pb & 15] = kb; sval[pb & 15] = b; sidx[pb & 15] = lane + 64; }
  WAVE_LDS_FENCE();
  {
    const unsigned mk = skey[lane & 15]; const float mv = sval[lane & 15]; const int mi = sidx[lane & 15];
    int rank = 0;
#pragma unroll
    for (int j4 = 0; j4 < 4; ++j4) {
      const u32x4 x = *(const u32x4*)(skey + 4 * j4);
#pragma unroll
      for (int e = 0; e < 4; ++e) rank += (x[e] > mk) ? 1 : 0;
    }
    if (lane < 16) { tv[rank] = mv; ti[rank] = mi; }
  }
  WAVE_LDS_FENCE();
}

__device__ __forceinline__ void peer_fma(const u32x4 (&u)[4], const unsigned (&hvp)[32], float& dot) {
#pragma unroll
  for (int i = 0; i < 4; ++i)
#pragma unroll
    for (int q = 0; q < 4; ++q) {
      const int wd = (int)u[i][q];
      const f32x2_t lo = __builtin_amdgcn_cvt_pk_f32_fp8(wd, false), hi = __builtin_amdgcn_cvt_pk_f32_fp8(wd, true);
      const unsigned h0 = hvp[8 * i + 2 * q], h1 = hvp[8 * i + 2 * q + 1];
      dot += lo[0] * bflo(h0) + lo[1] * bfhi(h0) + hi[0] * bflo(h1) + hi[1] * bfhi(h1);
    }
}
__device__ __forceinline__ void peer_axpy(const u32x4 (&v)[4], float coef, float (&acc)[64]) {
#pragma unroll
  for (int i = 0; i < 4; ++i)
#pragma unroll
    for (int q = 0; q < 4; ++q) {
      const int wd = (int)v[i][q];
      const f32x2_t lo = __builtin_amdgcn_cvt_pk_f32_fp8(wd, false), hi = __builtin_amdgcn_cvt_pk_f32_fp8(wd, true);
      acc[16 * i + 4 * q] += coef * lo[0]; acc[16 * i + 4 * q + 1] += coef * lo[1]; acc[16 * i + 4 * q + 2] += coef * hi[0]; acc[16 * i + 4 * q + 3] += coef * hi[1];
    }
}

__device__ __forceinline__ void phase10(const Params& p, unsigned char* smem) {
  unsigned char* ws = p.ws; const int tid = opaque_tid(), lane = tid & 63, w = tid >> 6;
  unsigned char* wb = smem + w * 4096;
  unsigned* skey = (unsigned*)wb;
  float* tv = (float*)(wb + 512);
  int* ti = (int*)(wb + 640);
  float* cs = (float*)(wb + 768);
  int* cf = (int*)(wb + 1024);
  float* ts = (float*)(wb + 1280);
  int* te = (int*)(wb + 1344);
  int* s_idx = (int*)(wb + 1536);
  float* s_gate = (float*)(wb + 2048);
  const float* SC = (const float*)(ws + OFF_SC); const bf16_t* hn = (const bf16_t*)(ws + OFF_A);
  const unsigned char* EU = ws + OFF_EU8; const unsigned char* EV = ws + OFF_EV8;
  const float* SU = (const float*)(ws + OFF_ESC); const float* SV = SU + 16384;
  int ci = 0, cj = 0;
  { int cnt = 0;
#pragma unroll
    for (int i = 0; i < 16; ++i) { const int n = 16 / (i + 1); if (lane >= cnt && lane < cnt + n) { ci = i; cj = lane - cnt; } cnt += n; } }
  for (int t = blockIdx.x; t < T_ / 4; t += gridDim.x) {
    const int tt = t * 4 + w;
    WAVE_LDS_FENCE();
    float sca[16], scb[16];
#pragma unroll
    for (int l = 0; l < 16; ++l) { sca[l] = SC[(size_t)tt * 2048 + l * 128 + lane]; scb[l] = SC[(size_t)tt * 2048 + l * 128 + 64 + lane]; }
#pragma unroll
    for (int h = 0; h < 8; ++h) {
      topk16_rank(sca[2 * h], scb[2 * h], lane, skey, tv, ti);
      topk16_rank(sca[2 * h + 1], scb[2 * h + 1], lane, skey, tv + 16, ti + 16);
      const float c = (lane < 50) ? tv[ci] + tv[16 + cj] : -INFINITY; const int fl = ci * 16 + cj;
      cs[lane] = c; cf[lane] = fl;
      WAVE_LDS_FENCE();
      int rank = 0;
#pragma unroll
      for (int l4 = 0; l4 < 13; ++l4) {
        const float4 c4 = *(const float4*)(cs + 4 * l4); const int4 f4 = *(const int4*)(cf + 4 * l4);
        rank += (c4.x > c || (c4.x == c && f4.x < fl)) ? 1 : 0; rank += (c4.y > c || (c4.y == c && f4.y < fl)) ? 1 : 0;
        rank += (c4.z > c || (c4.z == c && f4.z < fl)) ? 1 : 0; rank += (c4.w > c || (c4.w == c && f4.w < fl)) ? 1 : 0;
      }
      if (lane < 50 && rank < 16) { ts[rank] = c; te[rank] = ti[ci] * 128 + ti[16 + cj]; }
      WAVE_LDS_FENCE();
      const float tsv = ts[lane & 15]; const float ex = expf(tsv - ts[0]);
      float sum = ex; sum += __shfl_xor(sum, 8); sum += __shfl_xor(sum, 4); sum += __shfl_xor(sum, 2); sum += __shfl_xor(sum, 1);
      if (lane < 16) { s_idx[h * 16 + lane] = te[lane]; s_gate[h * 16 + lane] = ex / sum; }
    }
    WAVE_LDS_FENCE();
    unsigned hv[32]; float acc[64];
#pragma unroll
    for (int i = 0; i < 4; ++i) {
      const u32x4 h0 = *(const u32x4*)(hn + (size_t)tt * 4096 + 16 * (lane + 64 * i)), h1 = *(const u32x4*)(hn + (size_t)tt * 4096 + 16 * (lane + 64 * i) + 8);
#pragma unroll
      for (int q = 0; q < 4; ++q) { hv[8 * i + q] = h0[q]; hv[8 * i + 4 + q] = h1[q]; }
    }
#pragma unroll
    for (int i = 0; i < 64; ++i) acc[i] = 0.f;
    u32x4 ua[4], va[4], ub[4], vb[4];
    { const int idx = __builtin_amdgcn_readfirstlane(s_idx[0]);
#pragma unroll
      for (int i = 0; i < 4; ++i) { ua[i] = *(const u32x4*)(EU + (size_t)idx * 4096 + 16 * (lane + 64 * i)); va[i] = *(const u32x4*)(EV + (size_t)idx * 4096 + 16 * (lane + 64 * i)); } }
#pragma unroll 1
    for (int k = 0; k < 128; k += 2) {
      const int idxb = __builtin_amdgcn_readfirstlane(s_idx[k + 1]);
#pragma unroll
      for (int i = 0; i < 4; ++i) { ub[i] = *(const u32x4*)(EU + (size_t)idxb * 4096 + 16 * (lane + 64 * i)); vb[i] = *(const u32x4*)(EV + (size_t)idxb * 4096 + 16 * (lane + 64 * i)); }
      { const int idx = __builtin_amdgcn_readfirstlane(s_idx[k]); const float gt = s_gate[k];
        float dot = 0.f; peer_fma(ua, hv, dot);
        dot = wave_sum_fast(dot) * SU[idx];
        const float act = dot / (1.f + __expf(-1.5957691216057308f * (dot + 0.044715f * dot * dot * dot)));
        peer_axpy(va, gt * act * SV[idx], acc); }
      if (k + 2 < 128) {
        const int idxa = __builtin_amdgcn_readfirstlane(s_idx[k + 2]);
#pragma unroll
        for (int i = 0; i < 4; ++i) { ua[i] = *(const u32x4*)(EU + (size_t)idxa * 4096 + 16 * (lane + 64 * i)); va[i] = *(const u32x4*)(EV + (size_t)idxa * 4096 + 16 * (lane + 64 * i)); }
      }
      { const float gt = s_gate[k + 1];
        float dot = 0.f; peer_fma(ub, hv, dot);
        dot = wave_sum_fast(dot) * SU[idxb];
        const float act = dot / (1.f + __expf(-1.5957691216057308f * (dot + 0.044715f * dot * dot * dot)));
        peer_axpy(vb, gt * act * SV[idxb], acc); }
    }
    float4* op = (float4*)(p.out + (size_t)tt * D_);
#pragma unroll
    for (int i = 0; i < 4; ++i)
#pragma unroll
      for (int q = 0; q < 4; ++q) {
        float4 o = op[(lane + 64 * i) * 4 + q];
        o.x += acc[16 * i + 4 * q]; o.y += acc[16 * i + 4 * q + 1]; o.z += acc[16 * i + 4 * q + 2]; o.w += acc[16 * i + 4 * q + 3];
        op[(lane + 64 * i) * 4 + q] = o;
      }
  }
}


#define XB_TMO      128
#define XB_XCNT(j)  (256  + 64 * (j))
#define XB_XSUB(j)  (1280 + 64 * (j))
#define XB_XGEN(j)  (2304 + 64 * (j))
#define XB_TOP      3328
#define XB_TOPGEN   3392
#define XB_SPIN_CAP (1u << 18)
__device__ __forceinline__ unsigned xb_ld(unsigned* q)              { return __hip_atomic_load(q, __ATOMIC_RELAXED, __HIP_MEMORY_SCOPE_AGENT); }
__device__ __forceinline__ unsigned xb_add(unsigned* q, unsigned v) { return __hip_atomic_fetch_add(q, v, __ATOMIC_RELAXED, __HIP_MEMORY_SCOPE_AGENT); }
__device__ __forceinline__ unsigned xb_xcc_id() { return (unsigned)__builtin_amdgcn_s_getreg((3 << 11) | 20) & 0xFu; }
#define XB_SPIN(cond, bar) do { unsigned _sp = 0; while (cond) { __builtin_amdgcn_s_sleep(1); \
    if ((++_sp & 255u) == 0u) { if (xb_ld(&(bar)[XB_TMO])) break; if (_sp > XB_SPIN_CAP) { atomicAdd(&(bar)[XB_TMO], 1u); break; } } } } while (0)
struct XcdBarrier { unsigned* bar; unsigned x; volatile unsigned* st; };
__device__ __forceinline__ XcdBarrier xcd_barrier_post(unsigned* bar, volatile unsigned* st) {
  XcdBarrier b; b.bar = bar; b.x = xb_xcc_id(); b.st = st;
  if (threadIdx.x == 0) (void)xb_add(&bar[XB_XCNT(b.x)], 1u);
  return b;
}
__device__ __forceinline__ void xcd_barrier_complete(unsigned* bar, unsigned x, unsigned& nloc, unsigned& nx) {
  const unsigned G = gridDim.x * gridDim.y * gridDim.z;
  unsigned sum, cnt, mine, sp = 0u;
  for (;;) {
    sum = 0u; cnt = 0u; mine = 0u;
#pragma unroll
    for (unsigned j = 0; j < 16; ++j) { const unsigned c = xb_ld(&bar[XB_XCNT(j)]); sum += c; cnt += (c > 0u) ? 1u : 0u; mine = (j == x) ? c : mine; }
    if (sum == G) break;
    __builtin_amdgcn_s_sleep(1);
    if ((++sp & 255u) == 0u) { if (xb_ld(&bar[XB_TMO])) break; if (sp > XB_SPIN_CAP) { atomicAdd(&bar[XB_TMO], 1u); break; } }
  }
  nloc = mine > 0u ? mine : 1u; nx = cnt > 0u ? cnt : 1u;
}
__device__ __forceinline__ void xcd_barrier(const XcdBarrier& b) {
  asm volatile("s_waitcnt vmcnt(0)" ::: "memory");
  __syncthreads();
  if (threadIdx.x == 0) {
    unsigned* bar = b.bar;
    __builtin_amdgcn_s_waitcnt(0);
    unsigned nloc = b.st[0], nx = b.st[1];
    if (nloc == 0u) { xcd_barrier_complete(bar, b.x, nloc, nx); b.st[0] = nloc; b.st[1] = nx; }
    const unsigned old = xb_add(&bar[XB_XSUB(b.x)], 1u);
    const unsigned gen = old / nloc;
    if (old + 1u == (gen + 1u) * nloc) {
      __builtin_amdgcn_fence(__ATOMIC_RELEASE, "agent");
      asm volatile("s_waitcnt vmcnt(0)" ::: "memory");
      const unsigned og = xb_add(&bar[XB_TOP], 1u);
      const unsigned tg = og / nx;
      if (og + 1u == (tg + 1u) * nx) xb_add(&bar[XB_TOPGEN], 1u);
      else XB_SPIN(xb_ld(&bar[XB_TOPGEN]) == tg, bar);
      __builtin_amdgcn_fence(__ATOMIC_ACQUIRE, "agent");
      xb_add(&bar[XB_XGEN(b.x)], 1u);
      asm volatile("s_waitcnt vmcnt(0)" ::: "memory");
    } else {
      XB_SPIN(xb_ld(&bar[XB_XGEN(b.x)]) == gen, bar);
      __builtin_amdgcn_fence(__ATOMIC_ACQUIRE, "agent");
      asm volatile("s_waitcnt vmcnt(0)" ::: "memory");
    }
  }
  __syncthreads();
}

#ifndef PROBE_DUP
#define PROBE_DUP 0
#endif
#define RUN_PHASE(n) if (lo <= n && n < hi) { if (n > lo) xcd_barrier(xb); phase##n(p, smem); }
__global__ void __launch_bounds__(256, 2) fwd_megakernel(Params p) {
  extern __shared__ __attribute__((aligned(16))) unsigned char smem[];
  const int lo = (int)p.ph_lo, hi = (int)p.ph_hi;
  volatile unsigned* st = (volatile unsigned*)(smem + LDS_BYTES - 16);
  if (threadIdx.x < 2) st[threadIdx.x] = 0u;
  __syncthreads();
  XcdBarrier xb = xcd_barrier_post((unsigned*)(p.ws + OFF_BAR), st);
  if (hi > 1000) cg::this_grid().sync();
  RUN_PHASE(0) RUN_PHASE(1) RUN_PHASE(2) RUN_PHASE(3) RUN_PHASE(4) RUN_PHASE(5)
  RUN_PHASE(6) RUN_PHASE(7) RUN_PHASE(8) RUN_PHASE(9) RUN_PHASE(10)
}

extern "C" void kernel_launch(void* const* d_in, const int* in_sizes, int n_in, void* d_out, int out_size, void* d_ws, size_t ws_size,
                              hipStream_t stream) {
  static int grid_blocks = 0;
  if (!grid_blocks) {
    if (ws_size < OFF_END) { fprintf(stderr, "kernel_launch: workspace too small (%zu < %zu)\n", ws_size, (size_t)OFF_END); grid_blocks = -1; return; }
    int dev = 0, cus = 0, per_cu = 0;
    hipGetDevice(&dev);
    hipDeviceGetAttribute(&cus, hipDeviceAttributeMultiprocessorCount, dev);
    if (hipFuncSetAttribute((const void*)fwd_megakernel, hipFuncAttributeMaxDynamicSharedMemorySize, LDS_BYTES) != hipSuccess) { fprintf(stderr, "kernel_launch: hipFuncSetAttribute failed\n"); grid_blocks = -1; return; }
    hipOccupancyMaxActiveBlocksPerMultiprocessor(&per_cu, (const void*)fwd_megakernel, 256, LDS_BYTES);
    if (per_cu < 1) { fprintf(stderr, "kernel_launch: occupancy query returned %d\n", per_cu); per_cu = 1; }
    if (per_cu > 2) per_cu = 2;
    grid_blocks = cus * per_cu;
  }
  if (grid_blocks < 0) return;
  Params p{};
  p.x = (const float*)d_in[0]; p.pos = (const int*)d_in[1]; p.norm_mix = (const float*)d_in[2]; p.w_in = (const float*)d_in[3];
  p.q_a_norm = (const float*)d_in[4]; p.w_uq = (const float*)d_in[5]; p.kv_a_norm = (const float*)d_in[6]; p.w_ukv = (const float*)d_in[7];
  p.q_norm = (const float*)d_in[8]; p.k_norm = (const float*)d_in[9]; p.attn_out_norm = (const float*)d_in[10]; p.conv_w = (const float*)d_in[11];
  p.conv_b = (const float*)d_in[12]; p.a_log_f = (const float*)d_in[13]; p.a_log_b = (const float*)d_in[14]; p.dt_bias_f = (const float*)d_in[15];
  p.dt_bias_b = (const float*)d_in[16]; p.d_skip = (const float*)d_in[17]; p.ssm_out_norm = (const float*)d_in[18]; p.w_out = (const float*)d_in[19];
  p.norm_ffn = (const float*)d_in[20]; p.w_query = (const float*)d_in[21]; p.sub_keys = (const float*)d_in[22]; p.expert_u = (const float*)d_in[23];
  p.expert_v = (const float*)d_in[24];
  p.out = (float*)d_out; p.ws = (unsigned char*)d_ws;
#if ONE_LAUNCH
  p.ph_lo = 0; p.ph_hi = NPHASE;
  if (hipMemsetAsync((unsigned char*)d_ws + OFF_BAR, 0, BAR_BYTES, stream) != hipSuccess) { fprintf(stderr, "kernel_launch: hipMemsetAsync failed\n"); return; }
  void* args[] = {&p};
  hipError_t e = hipLaunchCooperativeKernel((const void*)fwd_megakernel, dim3(grid_blocks), dim3(256), args, LDS_BYTES, stream);
  if (e != hipSuccess) fprintf(stderr, "cooperative launch failed: %s (grid %d)\n", hipGetErrorString(e), grid_blocks);
#else
  for (int ph = 0; ph < NPHASE; ++ph) {
    p.ph_lo = ph; p.ph_hi = ph + 1;
    hipLaunchKernelGGL(fwd_megakernel, dim3(grid_blocks), dim3(256), LDS_BYTES, stream, p);
  }
#endif
}
```

```cpp
#include <hip/hip_runtime.h>
#include <hip/hip_cooperative_groups.h>
#include <cstdio>
#include <cstdint>
namespace cg = cooperative_groups;

typedef unsigned short bf16_t;
typedef __attribute__((ext_vector_type(8))) short bf16x8;
typedef __attribute__((ext_vector_type(4))) float f32x4;
typedef __attribute__((ext_vector_type(16))) float f32x16;
typedef __attribute__((ext_vector_type(4))) unsigned u32x4;
typedef __attribute__((ext_vector_type(2))) unsigned u32x2;

#ifndef ONE_LAUNCH
#define ONE_LAUNCH 1
#endif

constexpr int T_ = 8192, S_ = 2048, D_ = 4096, PJW = 7744;
constexpr int NPHASE = 11;
constexpr int FP8_EARLY = 3328;
constexpr int LDS_BYTES = 73728 + 256;
#ifndef GBM
#define GBM 256
#endif
#ifndef GNST
#define GNST 3
#endif

constexpr size_t SZ_WIN = (size_t)7808 * 4096 * 2, SZ_WUQ = (size_t)3072 * 1024 * 2, SZ_WUKV = (size_t)4096 * 512 * 2,
                 SZ_WOUT = (size_t)4096 * 4096 * 2, SZ_WQ = (size_t)2048 * 4096 * 2, SZ_SK = (size_t)16 * 128 * 128 * 2;
constexpr size_t OFF_WIN = 0, OFF_WUQ = OFF_WIN + SZ_WIN, OFF_WUKV = OFF_WUQ + SZ_WUQ, OFF_WOUT = OFF_WUKV + SZ_WUKV,
                 OFF_WQ = OFF_WOUT + SZ_WOUT, OFF_SK = OFF_WQ + SZ_WQ;
constexpr size_t OFF_A = OFF_SK + SZ_SK;
constexpr size_t OFF_B = OFF_A + (size_t)T_ * 4096 * 2;
constexpr size_t OFF_DTRAW = OFF_B + (size_t)T_ * PJW * 2;
constexpr size_t OFF_DT = OFF_DTRAW + (size_t)T_ * 64 * 4;
constexpr size_t OFF_ACUM = OFF_DT + (size_t)2 * T_ * 32 * 4;
constexpr size_t OFF_CQN = OFF_ACUM + (size_t)2 * T_ * 32 * 4;
constexpr size_t OFF_CKVN = OFF_CQN + (size_t)T_ * 1024 * 2;
constexpr size_t OFF_QRAW = OFF_CKVN + (size_t)T_ * 512 * 2;
constexpr size_t OFF_KVRAW = OFF_QRAW + (size_t)T_ * 3072 * 2;
constexpr size_t OFF_ST = OFF_KVRAW + (size_t)T_ * 4096 * 2;
constexpr size_t OFF_Q = OFF_ST + (size_t)2 * 4 * 16 * 32 * 64 * 128 * 2;
constexpr size_t OFF_K = OFF_Q + (size_t)4 * 16 * 2048 * 192 * 2;
constexpr size_t OFF_VT = OFF_K + (size_t)4 * 16 * 2048 * 192 * 2;
constexpr size_t OFF_EU8 = OFF_VT + (size_t)4 * 16 * 128 * 2048 * 2;
constexpr size_t OFF_EV8 = OFF_EU8 + (size_t)16384 * 4096;
constexpr size_t OFF_ESC = OFF_EV8 + (size_t)16384 * 4096;
constexpr size_t OFF_BAR = OFF_ESC + (size_t)2 * 16384 * 4;
constexpr size_t BAR_BYTES = 3456 * 4;
constexpr size_t OFF_END = OFF_BAR + 16384;
constexpr size_t OFF_QP = OFF_B;
constexpr size_t OFF_SC = OFF_B + (size_t)T_ * 2048 * 2;
constexpr size_t OFF_MIX = OFF_QRAW;

struct Params {
  const float* x; const int* pos; const float* norm_mix; const float* w_in; const float* q_a_norm; const float* w_uq;
  const float* kv_a_norm; const float* w_ukv; const float* q_norm; const float* k_norm; const float* attn_out_norm;
  const float* conv_w; const float* conv_b; const float* a_log_f; const float* a_log_b; const float* dt_bias_f; const float* dt_bias_b;
  const float* d_skip; const float* ssm_out_norm; const float* w_out; const float* norm_ffn; const float* w_query; const float* sub_keys;
  const float* expert_u; const float* expert_v;
  float* out; unsigned char* ws;
  long long ph_lo, ph_hi;
};

typedef __bf16 hwbf16x2 __attribute__((ext_vector_type(2)));
typedef float hwf32x2 __attribute__((ext_vector_type(2)));
__device__ __forceinline__ unsigned short f2bf(float f) { return __builtin_bit_cast(unsigned short, (__bf16)f); }
__device__ __forceinline__ float bf2f(unsigned short h) { return __uint_as_float(((unsigned)h) << 16); }
__device__ __forceinline__ unsigned pack2(float a, float b) { hwf32x2 f = {a, b}; return __builtin_bit_cast(unsigned, __builtin_convertvector(f, hwbf16x2)); }
__device__ __forceinline__ float bflo(unsigned u) { return __uint_as_float(u << 16); }
__device__ __forceinline__ float bfhi(unsigned u) { return __uint_as_float(u & 0xffff0000u); }
union U4B8 { uint4 u; bf16x8 v; };
__device__ __forceinline__ bf16x8 pack8(float a0, float a1, float a2, float a3, float a4, float a5, float a6, float a7) {
  U4B8 x; x.u = make_uint4(pack2(a0, a1), pack2(a2, a3), pack2(a4, a5), pack2(a6, a7)); return x.v;
}
__device__ __forceinline__ bf16x8 mk8(uint2 lo, uint2 hi) { U4B8 x; x.u = make_uint4(lo.x, lo.y, hi.x, hi.y); return x.v; }
__device__ __forceinline__ float wave_sum(float v) {
#pragma unroll
  for (int o = 32; o; o >>= 1) v += __shfl_xor(v, o);
  return v;
}
__device__ __forceinline__ void wave_argmax(float& v, int& i) {
#pragma unroll
  for (int o = 32; o; o >>= 1) {
    float ov = __shfl_xor(v, o); int oi = __shfl_xor(i, o);
    if (ov > v || (ov == v && oi < i)) { v = ov; i = oi; }
  }
}
__device__ __forceinline__ int opaque_tid() { int t = threadIdx.x; asm volatile("" : "+v"(t)); return t; }
__device__ __forceinline__ unsigned char* opaque_ptr(unsigned char* q) { asm volatile("" : "+s"(q)); return q; }
typedef float f32x2_t __attribute__((ext_vector_type(2)));
template <int CTRL> __device__ __forceinline__ float dppx(float v) { return __int_as_float(__builtin_amdgcn_update_dpp(0, __float_as_int(v), CTRL, 0xF, 0xF, true)); }
__device__ __forceinline__ float wave_sum_fast(float v) {
  v += dppx<0xB1>(v); v += dppx<0x4E>(v); v += dppx<0x141>(v); v += dppx<0x140>(v);
  const int iv = __float_as_int(v);
  return __int_as_float(__builtin_amdgcn_readlane(iv, 0)) + __int_as_float(__builtin_amdgcn_readlane(iv, 16)) +
         __int_as_float(__builtin_amdgcn_readlane(iv, 32)) + __int_as_float(__builtin_amdgcn_readlane(iv, 48));
}
__device__ __forceinline__ unsigned fkey(float f) { unsigned u = __float_as_uint(f); return (u & 0x80000000u) ? ~u : (u | 0x80000000u); }
__device__ __forceinline__ void fp8_row(const float* __restrict__ src, unsigned char* __restrict__ dst, float* __restrict__ scale_out, int lane) {
  float4 v[16]; float amax = 0.f;
#pragma unroll
  for (int j = 0; j < 16; ++j) {
    float4 t = ((const float4*)src)[lane + 64 * j]; v[j] = t;
    amax = fmaxf(amax, fmaxf(fmaxf(fabsf(t.x), fabsf(t.y)), fmaxf(fabsf(t.z), fabsf(t.w))));
  }
#pragma unroll
  for (int o = 32; o; o >>= 1) amax = fmaxf(amax, __shfl_xor(amax, o));
  const float sc = amax > 0.f ? 256.f / amax : 1.f;
  if (lane == 0) *scale_out = amax > 0.f ? amax * (1.f / 256.f) : 1.f;
#pragma unroll
  for (int j = 0; j < 16; ++j) {
    const float4 t = v[j];
    int wd = __builtin_amdgcn_cvt_pk_fp8_f32(t.x * sc, t.y * sc, 0, false);
    wd = __builtin_amdgcn_cvt_pk_fp8_f32(t.z * sc, t.w * sc, wd, true);
    ((unsigned*)dst)[lane + 64 * j] = (unsigned)wd;
  }
}
#define MFMA16(a, b, c) __builtin_amdgcn_mfma_f32_16x16x32_bf16(a, b, c, 0, 0, 0)
#define MFMA32(a, b, c) __builtin_amdgcn_mfma_f32_32x32x16_bf16(a, b, c, 0, 0, 0)

__device__ __forceinline__ void transpose_tile(const float* __restrict__ W, int K, int N, bf16_t* __restrict__ Wt, int tile, float* sm) {
  const int ntn = N >> 7; const int tk = tile / ntn, tn = tile - tk * ntn; const int k0 = tk << 6, n0 = tn << 7; const int tid = opaque_tid();
  float4 v[8];
#pragma unroll
  for (int i = 0; i < 8; ++i) v[i] = *(const float4*)(W + (size_t)(k0 + (tid >> 5) + 8 * i) * N + n0 + (tid & 31) * 4);
#pragma unroll
  for (int i = 0; i < 8; ++i) { float* d = sm + ((tid >> 5) + 8 * i) * 129 + (tid & 31) * 4; d[0] = v[i].x; d[1] = v[i].y; d[2] = v[i].z; d[3] = v[i].w; }
  __syncthreads();
#pragma unroll
  for (int i = 0; i < 4; ++i) {
    const int n = (tid >> 3) + 32 * i, kc = tid & 7; const float* s = sm + (kc * 8) * 129 + n;
    uint4 o; o.x = pack2(s[0], s[129]); o.y = pack2(s[258], s[387]); o.z = pack2(s[516], s[645]); o.w = pack2(s[774], s[903]);
    *(uint4*)(Wt + (size_t)(n0 + n) * K + k0 + kc * 8) = o;
  }
  __syncthreads();
}

template <int N>
__device__ __forceinline__ void rms_row_f32(const float* __restrict__ in, const float* __restrict__ gain, bf16_t* __restrict__ out, int lane) {
  constexpr int C = N / 256; float4 v[C]; float ss = 0.f;
#pragma unroll
  for (int i = 0; i < C; ++i) { v[i] = ((const float4*)in)[lane + 64 * i]; ss += v[i].x * v[i].x + v[i].y * v[i].y + v[i].z * v[i].z + v[i].w * v[i].w; }
  ss = wave_sum(ss); const float r = rsqrtf(ss * (1.f / N) + 1e-6f);
#pragma unroll
  for (int i = 0; i < C; ++i) {
    float4 g = ((const float4*)gain)[lane + 64 * i]; uint2 o;
    o.x = pack2(v[i].x * r * g.x, v[i].y * r * g.y); o.y = pack2(v[i].z * r * g.z, v[i].w * r * g.w);
    ((uint2*)out)[lane + 64 * i] = o;
  }
}
template <int N>
__device__ __forceinline__ void rms_row_bf16(const bf16_t* __restrict__ in, const float* __restrict__ gain, bf16_t* __restrict__ out, int lane) {
  constexpr int C = N / 256; uint2 v[C]; float ss = 0.f;
#pragma unroll
  for (int i = 0; i < C; ++i) { v[i] = ((const uint2*)in)[lane + 64 * i]; float a = bflo(v[i].x), b = bfhi(v[i].x), c = bflo(v[i].y), d = bfhi(v[i].y); ss += a * a + b * b + c * c + d * d; }
  ss = wave_sum(ss); const float r = rsqrtf(ss * (1.f / N) + 1e-6f);
#pragma unroll
  for (int i = 0; i < C; ++i) {
    float4 g = ((const float4*)gain)[lane + 64 * i]; uint2 o;
    o.x = pack2(bflo(v[i].x) * r * g.x, bfhi(v[i].x) * r * g.y); o.y = pack2(bflo(v[i].y) * r * g.z, bfhi(v[i].y) * r * g.w);
    ((uint2*)out)[lane + 64 * i] = o;
  }
}

#define GEMM_WAITV(n) asm volatile("s_waitcnt vmcnt(" #n ")" ::: "memory")
#define GEMM_RAWBAR() do { asm volatile("s_waitcnt lgkmcnt(0)" ::: "memory"); __builtin_amdgcn_s_barrier(); } while (0)
template <int BM, int NST, class Epi>
__device__ __forceinline__ void gemm_tile(const bf16_t* __restrict__ A, int lda, const bf16_t* __restrict__ B, int ldb, int K, int m0, int n0,
                                          unsigned char* smem, const Epi& epi) {
  constexpr int MI = BM / 32, NA = BM / 64, NV = NA + 2, D = NST - 1, STAGE_EL = (BM + 128) * 32;
  static_assert(NST == 3 || NST == 4, "ring depth");
  bf16_t* ring = (bf16_t*)smem;
  const int tid = opaque_tid(), lane = tid & 63, w = __builtin_amdgcn_readfirstlane(tid >> 6), wm = w >> 1, wn = w & 1;
  f32x4 acc[MI][4];
#pragma unroll
  for (int i = 0; i < MI; ++i)
#pragma unroll
    for (int j = 0; j < 4; ++j) acc[i][j] = (f32x4){0.f, 0.f, 0.f, 0.f};
  const int srow = tid >> 2, slc = (tid & 3) ^ ((tid >> 4) & 3);
  const bf16_t* Ag = A + (size_t)(m0 + srow) * lda + slc * 8;
  const bf16_t* Bg = B + (size_t)(n0 + srow) * ldb + slc * 8;
  const int nk = K >> 5;
#define GEMM_ISSUE(st, k0)                                                                                                     \
  do { bf16_t* sa_ = ring + (st) * STAGE_EL; bf16_t* sb_ = sa_ + BM * 32;                                                      \
    _Pragma("unroll") for (int i = 0; i < NA; ++i)                                                                             \
      __builtin_amdgcn_global_load_lds((const unsigned*)(Ag + (size_t)(64 * i) * lda + (k0)), (unsigned*)(sa_ + (i * 256 + w * 64) * 8), 16, 0, 0); \
    _Pragma("unroll") for (int i = 0; i < 2; ++i)                                                                              \
      __builtin_amdgcn_global_load_lds((const unsigned*)(Bg + (size_t)(64 * i) * ldb + (k0)), (unsigned*)(sb_ + (i * 256 + w * 64) * 8), 16, 0, 0); \
  } while (0)
  GEMM_ISSUE(0, 0);
  if (nk > 1) GEMM_ISSUE(1, 32);
  if (D >= 3 && nk > 2) GEMM_ISSUE(2, 64);
  const int fr = lane & 15, fq = lane >> 4;
  const int foff = fr * 32 + ((fq ^ ((fr >> 2) & 3)) * 8);
  int st = 0, stn = D % NST;
  for (int kt = 0; kt < nk; ++kt) {
    const int rem = min(D - 1, nk - 1 - kt);
    if (rem >= 2) { if (NV == 4) GEMM_WAITV(8); else GEMM_WAITV(12); }
    else if (rem == 1) { if (NV == 4) GEMM_WAITV(4); else GEMM_WAITV(6); }
    else GEMM_WAITV(0);
    GEMM_RAWBAR();
    const bf16_t* a_ = ring + st * STAGE_EL + (wm * (BM / 2)) * 32 + foff;
    const bf16_t* b_ = ring + st * STAGE_EL + BM * 32 + (wn * 64) * 32 + foff;
    bf16x8 af[MI], bfr[4];
#pragma unroll
    for (int j = 0; j < 4; ++j) bfr[j] = *(const bf16x8*)(b_ + j * 16 * 32);
#pragma unroll
    for (int i = 0; i < MI; ++i) af[i] = *(const bf16x8*)(a_ + i * 16 * 32);
    __builtin_amdgcn_sched_barrier(0);
    if (kt + D < nk) {
      bf16_t* sa_ = ring + stn * STAGE_EL; bf16_t* sb_ = sa_ + BM * 32; const int k0n = (kt + D) << 5;
#pragma unroll
      for (int i = 0; i < MI; ++i) {
#pragma unroll
        for (int j = 0; j < 4; ++j) acc[i][j] = MFMA16(af[i], bfr[j], acc[i][j]);
        if (i < NA) __builtin_amdgcn_global_load_lds((const unsigned*)(Ag + (size_t)(64 * i) * lda + k0n), (unsigned*)(sa_ + (i * 256 + w * 64) * 8), 16, 0, 0);
        else if (i < NV) __builtin_amdgcn_global_load_lds((const unsigned*)(Bg + (size_t)(64 * (i - NA)) * ldb + k0n), (unsigned*)(sb_ + ((i - NA) * 256 + w * 64) * 8), 16, 0, 0);
        __builtin_amdgcn_sched_barrier(0);
      }
    } else {
#pragma unroll
      for (int i = 0; i < MI; ++i)
#pragma unroll
        for (int j = 0; j < 4; ++j) acc[i][j] = MFMA16(af[i], bfr[j], acc[i][j]);
    }
    st = (st + 1 == NST) ? 0 : st + 1; stn = (stn + 1 == NST) ? 0 : stn + 1;
  }
  GEMM_RAWBAR();
#undef GEMM_ISSUE
  {
    float* stg = (float*)(smem + w * 18432);
    constexpr int SSTR = 68;
#pragma unroll
    for (int h = 0; h < MI / 4; ++h) {
#pragma unroll
      for (int i4 = 0; i4 < 4; ++i4)
#pragma unroll
        for (int j = 0; j < 4; ++j)
#pragma unroll
          for (int r = 0; r < 4; ++r) stg[(i4 * 16 + (lane >> 4) * 4 + r) * SSTR + j * 16 + (lane & 15)] = acc[h * 4 + i4][j][r];
      asm volatile("s_waitcnt lgkmcnt(0)" ::: "memory");
#pragma unroll
      for (int it = 0; it < 16; ++it) {
        const int rr = it * 4 + (lane >> 4);
        const float4 v = *(const float4*)(stg + rr * SSTR + (lane & 15) * 4);
        epi.store4(m0 + wm * (BM / 2) + h * 64 + rr, n0 + wn * 64 + (lane & 15) * 4, v);
      }
      asm volatile("s_waitcnt lgkmcnt(0)" ::: "memory");
    }
  }
  asm volatile("s_waitcnt vmcnt(0)" ::: "memory");
  GEMM_RAWBAR();
}

template <class F>
__device__ __forceinline__ void for_gemm_tiles(int MT, int NT, F f) {
  const int xcd = blockIdx.x & 7, local = blockIdx.x >> 3, nloc = gridDim.x >> 3;
  const int SM = (MT + 7) >> 3, SN = (NT + 7) >> 3, nsup = SM * SN, per_xcd = (nsup + 7) >> 3;
  for (int idx = local; idx < per_xcd * 64; idx += nloc) {
    const int st = (idx >> 6) * 8 + xcd; if (st >= nsup) continue;
    const int within = idx & 63; const int mt = (st / SN) * 8 + (within >> 3), nt = (st % SN) * 8 + (within & 7);
    if (mt < MT && nt < NT) f(mt, nt);
  }
}

struct EpiProj { bf16_t* proj; float* dtraw;
  __device__ __forceinline__ void store4(int r, int c, float4 v) const {
    if (c < PJW) { uint2 o; o.x = pack2(v.x, v.y); o.y = pack2(v.z, v.w); *(uint2*)(proj + (size_t)r * PJW + c) = o; }
    else *(float4*)(dtraw + r * 64 + c - PJW) = v; } };
struct EpiBf16 { bf16_t* o; int ld;
  __device__ __forceinline__ void store4(int r, int c, float4 v) const { uint2 t; t.x = pack2(v.x, v.y); t.y = pack2(v.z, v.w); *(uint2*)(o + (size_t)r * ld + c) = t; } };
struct EpiOut { const float* x; float* o;
  __device__ __forceinline__ void store4(int r, int c, float4 v) const { size_t i = (size_t)r * D_ + c; float4 xv = *(const float4*)(x + i); *(float4*)(o + i) = make_float4(xv.x + v.x, xv.y + v.y, xv.z + v.z, xv.w + v.w); } };
struct EpiF32 { float* o; int ld;
  __device__ __forceinline__ void store4(int r, int c, float4 v) const { *(float4*)(o + (size_t)r * ld + c) = v; } };

__device__ __forceinline__ void late_transposes(const Params& p, int first, int stride, unsigned char* smem) {
  unsigned char* ws = p.ws;
  for (int t = first; t < 3072; t += stride) {
    if (t < 2048) transpose_tile(p.w_out, 4096, 4096, (bf16_t*)(ws + OFF_WOUT), t, (float*)smem);
    else transpose_tile(p.w_query, 4096, 2048, (bf16_t*)(ws + OFF_WQ), t - 2048, (float*)smem);
  }
}

__device__ __forceinline__ void fp8_convert_tiles(const Params& p, int first, int stride) {
  unsigned char* ws = p.ws; const float* eu = p.expert_u; const float* ev = p.expert_v;
  for (int t = first; t < 8192; t += stride) {
    const int tid2 = opaque_tid(); const int row = t * 4 + (tid2 >> 6); const int tb = row >> 14, r = row & 16383;
    fp8_row((tb ? ev : eu) + (size_t)r * 4096, ws + (tb ? OFF_EV8 : OFF_EU8) + (size_t)r * 4096, (float*)(ws + OFF_ESC) + row, tid2 & 63);
  }
}

__device__ __forceinline__ void phase0(const Params& p, unsigned char* smem) {
  unsigned char* ws = p.ws;
  const int n0 = 3904, n1 = n0 + 384, n2 = n1 + 256, n3 = n2 + 2048, n4 = n3 + 1024, n5 = n4 + 64, n6 = n5 + 2048;
  if (gridDim.x != 512) fp8_convert_tiles(p, blockIdx.x, gridDim.x);
  const int tid = opaque_tid(), lane = tid & 63, w = tid >> 6;
  for (int t = blockIdx.x; t < n6; t += gridDim.x) {
    if (t < n0) transpose_tile(p.w_in, 4096, 7808, (bf16_t*)(ws + OFF_WIN), t, (float*)smem);
    else if (t < n1) transpose_tile(p.w_uq, 1024, 3072, (bf16_t*)(ws + OFF_WUQ), t - n0, (float*)smem);
    else if (t < n2) transpose_tile(p.w_ukv, 512, 4096, (bf16_t*)(ws + OFF_WUKV), t - n1, (float*)smem);
    else if (t < n4) { if (gridDim.x != 512) late_transposes(p, t - n2, 1 << 30, smem); }

    else if (t < n5) {
      const int base = (t - n4) * 4096; bf16_t* sk = (bf16_t*)(ws + OFF_SK);
#pragma unroll
      for (int i = 0; i < 4; ++i) { int e = base + (tid + 256 * i) * 4; float4 v = *(const float4*)(p.sub_keys + e); uint2 o; o.x = pack2(v.x, v.y); o.y = pack2(v.z, v.w); *(uint2*)(sk + e) = o; }
    } else {
      const int row = (t - n5) * 4 + w;
      rms_row_f32<4096>(p.x + (size_t)row * D_, p.norm_mix, (bf16_t*)(ws + OFF_A) + (size_t)row * D_, lane);
    }
  }
}

__device__ __forceinline__ void phase1(const Params& p, unsigned char* smem) {
  unsigned char* ws = p.ws;
  EpiProj epi{(bf16_t*)(ws + OFF_B), (float*)(ws + OFF_DTRAW)};
  const bf16_t* A = (const bf16_t*)(ws + OFF_A); const bf16_t* B = (const bf16_t*)(ws + OFF_WIN);
  for_gemm_tiles(T_ / GBM, 61, [&](int mt, int nt) { gemm_tile<GBM, GNST>(A, 4096, B, 4096, 4096, mt * GBM, nt * 128, smem, epi); });
  if (gridDim.x == 512 && (blockIdx.x & 7) == 7 && ((blockIdx.x >> 3) & 7) >= 5) {
    const int local = blockIdx.x >> 3; const int bi = (local >> 3) * 3 + ((local & 7) - 5);
    for (int t = bi; t < FP8_EARLY; t += 24) fp8_convert_tiles(p, t, 1 << 30);
  }
}

__device__ __forceinline__ void phase2(const Params& p, unsigned char* smem) {
  unsigned char* ws = p.ws;
  const int tid = opaque_tid(), lane = tid & 63, w = tid >> 6;
  const bf16_t* proj = (const bf16_t*)(ws + OFF_B);
  for (int t = blockIdx.x; t < 16; t += gridDim.x) {
    const int gid = t * 256 + tid; const int h = gid & 31, c = (gid >> 5) & 15, b = (gid >> 9) & 3, dir = gid >> 11;
    const float alf = p.a_log_f[h], alb = p.a_log_b[h], dbf = p.dt_bias_f[h], dbb = p.dt_bias_b[h];
    const float a = -expf(dir ? alb : alf); const float bias = dir ? dbb : dbf;
    const float* dtraw = (const float*)(ws + OFF_DTRAW) + dir * 32 + h; float* DT = (float*)(ws + OFF_DT) + (size_t)dir * T_ * 32 + h; float* AC = (float*)(ws + OFF_ACUM) + (size_t)dir * T_ * 32 + h;
    const int tbase = b * S_ + c * 128; const int l0 = dir ? 127 : 0, ls = dir ? -1 : 1;
    float cum = 0.f;
#pragma unroll 1
    for (int i0 = 0; i0 < 128; i0 += 16) {
      float raw[16];
#pragma unroll
      for (int j = 0; j < 16; ++j) raw[j] = dtraw[(tbase + l0 + ls * (i0 + j)) * 64];
#pragma unroll
      for (int j = 0; j < 16; ++j) {
        const int tt = tbase + l0 + ls * (i0 + j);
        const float r = raw[j] + bias; const float dt = fmaxf(r, 0.f) + log1pf(expf(-fabsf(r)));
        cum += dt * a; DT[tt * 32] = dt; AC[tt * 32] = cum;
      }
    }
  }
  for (int t = blockIdx.x; t < T_ / 4; t += gridDim.x) {
    const int row = t * 4 + w;
    rms_row_bf16<1024>(proj + (size_t)row * PJW, p.q_a_norm, (bf16_t*)(ws + OFF_CQN) + (size_t)row * 1024, lane);
    rms_row_bf16<512>(proj + (size_t)row * PJW + 1024, p.kv_a_norm, (bf16_t*)(ws + OFF_CKVN) + (size_t)row * 512, lane);
  }
  bf16_t* xc = (bf16_t*)(ws + OFF_A);
  for (int t = blockIdx.x; t < T_ / 4 * 2; t += gridDim.x) {
    const int idx = t * 256 + tid; const int tg = idx >> 9, c = (idx & 511) * 8; const int t0 = tg * 4; const int s0 = t0 & (S_ - 1);
    u32x4 rows[8];
#pragma unroll
    for (int j = 0; j < 8; ++j) {
      const int ss = s0 + j - 2;
      rows[j] = (ss >= 0 && ss < S_) ? *(const u32x4*)(proj + (size_t)(t0 + j - 2) * PJW + 3648 + c) : (u32x4){0u, 0u, 0u, 0u};
    }
    float wgt[5][8], bia[8];
#pragma unroll
    for (int wv = 0; wv < 5; ++wv) {
      const float4 w0 = *(const float4*)(p.conv_w + wv * 4096 + c), w1 = *(const float4*)(p.conv_w + wv * 4096 + c + 4);
      wgt[wv][0] = w0.x; wgt[wv][1] = w0.y; wgt[wv][2] = w0.z; wgt[wv][3] = w0.w; wgt[wv][4] = w1.x; wgt[wv][5] = w1.y; wgt[wv][6] = w1.z; wgt[wv][7] = w1.w;
    }
    { const float4 b0 = *(const float4*)(p.conv_b + c), b1 = *(const float4*)(p.conv_b + c + 4); bia[0] = b0.x; bia[1] = b0.y; bia[2] = b0.z; bia[3] = b0.w; bia[4] = b1.x; bia[5] = b1.y; bia[6] = b1.z; bia[7] = b1.w; }
#pragma unroll
    for (int o = 0; o < 4; ++o) {
      float acc[8];
#pragma unroll
      for (int e = 0; e < 8; ++e) acc[e] = bia[e];
#pragma unroll
      for (int wv = 0; wv < 5; ++wv) {
        const u32x4 v = rows[o + wv];
#pragma unroll
        for (int q = 0; q < 4; ++q) { acc[2 * q] += bflo(v[q]) * wgt[wv][2 * q]; acc[2 * q + 1] += bfhi(v[q]) * wgt[wv][2 * q + 1]; }
      }
#pragma unroll
      for (int e = 0; e < 8; ++e) acc[e] = acc[e] / (1.f + __expf(-acc[e]));
      u32x4 ov; ov[0] = pack2(acc[0], acc[1]); ov[1] = pack2(acc[2], acc[3]); ov[2] = pack2(acc[4], acc[5]); ov[3] = pack2(acc[6], acc[7]);
      *(u32x4*)(xc + (size_t)(t0 + o) * 4096 + c) = ov;
    }
  }
}

__device__ __forceinline__ void ssd_states_tile(const Params& p, int tile, unsigned char* smem) {
  unsigned char* ws = p.ws;
  const int g = tile & 7, c = (tile >> 3) & 15, b = tile >> 7; const int t0 = b * S_ + c * 128;
  const int tid = opaque_tid(), lane = tid & 63, w = tid >> 6;
  bf16_t* sBT = (bf16_t*)smem;
  bf16_t* sXT = sBT + 128 * 136;
  const bf16_t* xc = (const bf16_t*)(ws + OFF_A);
#pragma unroll
  for (int i = 0; i < 4; ++i) {
    const int item = tid + 256 * i; const int lp = item >> 4, nc = item & 15;
    uint4 v0 = *(const uint4*)(xc + (size_t)(t0 + 2 * lp) * 4096 + 2048 + g * 128 + nc * 8);
    uint4 v1 = *(const uint4*)(xc + (size_t)(t0 + 2 * lp + 1) * 4096 + 2048 + g * 128 + nc * 8);
    unsigned a0[4] = {v0.x, v0.y, v0.z, v0.w}, a1[4] = {v1.x, v1.y, v1.z, v1.w};
#pragma unroll
    for (int j = 0; j < 4; ++j) {
      *(unsigned*)(sBT + (nc * 8 + 2 * j) * 136 + 2 * lp) = (a0[j] & 0xffffu) | (a1[j] << 16);
      *(unsigned*)(sBT + (nc * 8 + 2 * j + 1) * 136 + 2 * lp) = (a0[j] >> 16) | (a1[j] & 0xffff0000u);
    }
  }
#pragma unroll 1
  for (int dr = 0; dr < 8; ++dr) {
    const int dir = dr >> 2, r = dr & 3, hd = g * 4 + r;
    const float* DT = (const float*)(ws + OFF_DT) + (size_t)dir * T_ * 32; const float* AC = (const float*)(ws + OFF_ACUM) + (size_t)dir * T_ * 32;
    const float aend = AC[(t0 + (dir ? 0 : 127)) * 32 + hd];
#pragma unroll
    for (int i = 0; i < 2; ++i) {
      const int item = tid + 256 * i; const int lp = item >> 3, pc = item & 7;
      const int l0 = 2 * lp, l1 = 2 * lp + 1;
      const float w0 = DT[(t0 + l0) * 32 + hd] * expf(aend - AC[(t0 + l0) * 32 + hd]);
      const float w1 = DT[(t0 + l1) * 32 + hd] * expf(aend - AC[(t0 + l1) * 32 + hd]);
      uint4 v0 = *(const uint4*)(xc + (size_t)(t0 + l0) * 4096 + hd * 64 + pc * 8);
      uint4 v1 = *(const uint4*)(xc + (size_t)(t0 + l1) * 4096 + hd * 64 + pc * 8);
      unsigned a0[4] = {v0.x, v0.y, v0.z, v0.w}, a1[4] = {v1.x, v1.y, v1.z, v1.w};
#pragma unroll
      for (int j = 0; j < 4; ++j) {
        *(unsigned*)(sXT + (pc * 8 + 2 * j) * 136 + l0) = pack2(bflo(a0[j]) * w0, bflo(a1[j]) * w1);
        *(unsigned*)(sXT + (pc * 8 + 2 * j + 1) * 136 + l0) = pack2(bfhi(a0[j]) * w0, bfhi(a1[j]) * w1);
      }
    }
    __syncthreads();
    f32x4 acc[8];
#pragma unroll
    for (int j = 0; j < 8; ++j) acc[j] = (f32x4){0.f, 0.f, 0.f, 0.f};
#pragma unroll
    for (int ks = 0; ks < 4; ++ks) {
      bf16x8 af = *(const bf16x8*)(sXT + (16 * w + (lane & 15)) * 136 + ks * 32 + (lane >> 4) * 8);
#pragma unroll
      for (int j = 0; j < 8; ++j) {
        bf16x8 bfr = *(const bf16x8*)(sBT + (j * 16 + (lane & 15)) * 136 + ks * 32 + (lane >> 4) * 8);
        acc[j] = MFMA16(af, bfr, acc[j]);
      }
    }
    bf16_t* st = (bf16_t*)(ws + OFF_ST) + ((((size_t)(dir * 4 + b) * 16 + c) * 32 + hd) * 64) * 128;
    bf16_t* stg = sXT + 64 * 136 + w * (16 * 136);
#pragma unroll
    for (int j = 0; j < 8; ++j)
#pragma unroll
      for (int rr = 0; rr < 4; ++rr) stg[((lane >> 4) * 4 + rr) * 136 + j * 16 + (lane & 15)] = f2bf(acc[j][rr]);
    asm volatile("s_waitcnt lgkmcnt(0)" ::: "memory");
#pragma unroll
    for (int q = 0; q < 4; ++q) {
      const int cc = lane + 64 * q; const int row = cc >> 4, ch = cc & 15;
      *(u32x4*)(st + (16 * w + row) * 128 + ch * 8) = *(const u32x4*)(stg + row * 136 + ch * 8);
    }
    __syncthreads();
  }
}

__device__ __forceinline__ void phase3(const Params& p, unsigned char* smem) {
  unsigned char* ws = p.ws;
  { EpiBf16 epi{(bf16_t*)(ws + OFF_QRAW), 3072};
    const bf16_t* A = (const bf16_t*)(ws + OFF_CQN); const bf16_t* B = (const bf16_t*)(ws + OFF_WUQ);
    for_gemm_tiles(T_ / GBM, 24, [&](int mt, int nt) { gemm_tile<GBM, GNST>(A, 1024, B, 1024, 1024, mt * GBM, nt * 128, smem, epi); }); }
  { EpiBf16 epi{(bf16_t*)(ws + OFF_KVRAW), 4096};
    const bf16_t* A = (const bf16_t*)(ws + OFF_CKVN); const bf16_t* B = (const bf16_t*)(ws + OFF_WUKV);
    for_gemm_tiles(T_ / GBM, 32, [&](int mt, int nt) { gemm_tile<GBM, GNST>(A, 512, B, 512, 512, mt * GBM, nt * 128, smem, epi); }); }
  if (gridDim.x == 512 && (blockIdx.x & 7) >= 4) late_transposes(p, (blockIdx.x >> 3) * 4 + ((blockIdx.x & 7) - 4), 256, smem);
  for (int t = blockIdx.x; t < 512; t += gridDim.x) ssd_states_tile(p, t, smem);
}

__device__ __forceinline__ void phase4(const Params& p, unsigned char* smem) {
  unsigned char* ws = p.ws;
  const int tid = opaque_tid(), lane = tid & 63, w = tid >> 6;
  for (int t = blockIdx.x; t < 1024; t += gridDim.x) {
    const int gid = t * 256 + tid; const int nch = gid & 15, pp = (gid >> 4) & 63, h = (gid >> 10) & 31, b = (gid >> 15) & 3, dir = gid >> 17;
    const float* AC = (const float*)(ws + OFF_ACUM) + (size_t)dir * T_ * 32;
    bf16_t* base = (bf16_t*)(ws + OFF_ST) + ((((size_t)(dir * 4 + b) * 16) * 32 + h) * 64 + pp) * 128 + nch * 8;
    u32x4 sv[16]; float dec[16];
#pragma unroll
    for (int i = 0; i < 16; ++i) {
      const int c = dir ? 15 - i : i;
      sv[i] = *(const u32x4*)(base + (size_t)c * (32 * 64 * 128));
      dec[i] = AC[(b * S_ + c * 128 + (dir ? 0 : 127)) * 32 + h];
    }
    float hs[8];
#pragma unroll
    for (int j = 0; j < 8; ++j) hs[j] = 0.f;
#pragma unroll
    for (int i = 0; i < 16; ++i) {
      const int c = dir ? 15 - i : i;
      u32x4 o; o[0] = pack2(hs[0], hs[1]); o[1] = pack2(hs[2], hs[3]); o[2] = pack2(hs[4], hs[5]); o[3] = pack2(hs[6], hs[7]);
      *(u32x4*)(base + (size_t)c * (32 * 64 * 128)) = o;
      const float d = expf(dec[i]);
#pragma unroll
      for (int q = 0; q < 4; ++q) { hs[2 * q] = hs[2 * q] * d + bflo(sv[i][q]); hs[2 * q + 1] = hs[2 * q + 1] * d + bfhi(sv[i][q]); }
    }
  }
  const bf16_t* proj = (const bf16_t*)(ws + OFF_B);
  const bf16_t* qraw = (const bf16_t*)(ws + OFF_QRAW); const bf16_t* kvraw = (const bf16_t*)(ws + OFF_KVRAW);
  const float qscale = 0.07216878364870322f * 1.4426950408889634f;
  const float* const qn_ = p.q_norm; const float* const kn_ = p.k_norm; const int* const pos_ = p.pos;
  const float gq0 = qn_[lane], gq1 = qn_[lane + 64], gq2 = qn_[lane + 128], gk0 = kn_[lane], gk1 = kn_[lane + 64], gk2 = kn_[lane + 128];
  const float invf = exp2f(-(float)(lane & 31) * (13.287712379549449f / 32.f));
  for (int tt = blockIdx.x * 4 + w; tt < T_; tt += gridDim.x * 4) {
    const float posf = (float)pos_[tt];
    float sn, cs; sincosf(posf * invf, &sn, &cs);
    const int b = tt >> 11, sq = tt & (S_ - 1);
    const float kr = bf2f(proj[(size_t)tt * PJW + 1536 + lane]);
    float x0[4], x1[4], x2[4], n0[4], n1[4], n2[4];
#define QK_LOAD(HQ, X0, X1, X2) do { const int wh_ = (HQ) >> 2, hh_ = ((HQ) & 3) * 4;                                       \
      _Pragma("unroll") for (int j = 0; j < 4; ++j) {                                                                       \
        const bf16_t* sp = wh_ ? (kvraw + (size_t)tt * 4096 + (hh_ + j) * 256) : (qraw + (size_t)tt * 3072 + (hh_ + j) * 192); \
        X0[j] = bf2f(sp[lane]); X1[j] = bf2f(sp[lane + 64]); X2[j] = wh_ ? kr : bf2f(sp[lane + 128]); } } while (0)
#define QK_PROC(HQ, X0, X1, X2) do { const int which = (HQ) >> 2, h0 = ((HQ) & 3) * 4;                                      \
      const float g0 = which ? gk0 : gq0, g1 = which ? gk1 : gq1, g2 = which ? gk2 : gq2;                                  \
      const float scl = which ? 1.f : qscale;                                                                               \
      bf16_t* dbase = (bf16_t*)(ws + (which == 0 ? OFF_Q : OFF_K)) + ((size_t)(b * 16 + h0) * S_ + sq) * 192;              \
      _Pragma("unroll") for (int j = 0; j < 4; ++j) {                                                                       \
        const float ss = wave_sum_fast(X0[j] * X0[j] + X1[j] * X1[j] + X2[j] * X2[j]);                                      \
        const float r = rsqrtf(ss * (1.f / 192.f) + 1e-6f);                                                                 \
        const float y0 = X0[j] * r * g0, y1 = X1[j] * r * g1, y2 = X2[j] * r * g2;                                          \
        const float other = __shfl_xor(y2, 32);                                                                             \
        const float yr = (lane < 32) ? (y2 * cs - other * sn) : (other * sn + y2 * cs);                                     \
        bf16_t* dst = dbase + (size_t)j * S_ * 192;                                                                         \
        dst[lane] = f2bf(y0 * scl); dst[lane + 64] = f2bf(y1 * scl); dst[lane + 128] = f2bf(yr * scl); } } while (0)
    QK_LOAD(0, x0, x1, x2);
#pragma unroll 1
    for (int hq = 0; hq < 8; hq += 2) {
      QK_LOAD(hq + 1, n0, n1, n2);
      QK_PROC(hq, x0, x1, x2);
      if (hq + 2 < 8) QK_LOAD(hq + 2, x0, x1, x2);
      QK_PROC(hq + 1, n0, n1, n2);
    }
#undef QK_LOAD
#undef QK_PROC
  }
  bf16_t* sm = (bf16_t*)smem;
  for (int t = blockIdx.x; t < 2048; t += gridDim.x) {
    const int sb = t & 31, head = (t >> 5) & 15, b = t >> 9; const int tbase = b * S_ + sb * 64;
    __syncthreads();
#pragma unroll
    for (int i = 0; i < 4; ++i) {
      const int cidx = tid + 256 * i; const int srow = cidx >> 4, dc = cidx & 15;
      uint4 v = *(const uint4*)(kvraw + (size_t)(tbase + srow) * 4096 + head * 256 + 128 + dc * 8);
      unsigned a[4] = {v.x, v.y, v.z, v.w};
#pragma unroll
      for (int j = 0; j < 4; ++j) { sm[(dc * 8 + 2 * j) * 72 + srow] = (bf16_t)(a[j] & 0xffffu); sm[(dc * 8 + 2 * j + 1) * 72 + srow] = (bf16_t)(a[j] >> 16); }
    }
    __syncthreads();
    bf16_t* vt = (bf16_t*)(ws + OFF_VT) + (size_t)(b * 16 + head) * 128 * S_ + sb * 64;
#pragma unroll
    for (int i = 0; i < 4; ++i) {
      const int cidx = tid + 256 * i; const int d = cidx >> 3, sc8 = cidx & 7;
      *(uint4*)(vt + (size_t)d * S_ + sc8 * 8) = *(const uint4*)(sm + d * 72 + sc8 * 8);
    }
  }
}

__device__ __forceinline__ void attn_tile(const Params& p, int tile, unsigned char* smem) {
  unsigned char* ws = p.ws;
  const int qb = tile & 15, head = (tile >> 4) & 15, b = tile >> 8;
  const int tid = opaque_tid(), lane = tid & 63, w = tid >> 6, lr = lane & 31, lh = lane >> 5;
  bf16_t* sK = (bf16_t*)smem;
  bf16_t* sV = sK + 64 * 200;
  const bf16_t* Qp = (const bf16_t*)(ws + OFF_Q) + ((size_t)(b * 16 + head) * S_ + qb * 128 + w * 32) * 192;
  const bf16_t* Kp = (const bf16_t*)(ws + OFF_K) + (size_t)(b * 16 + head) * S_ * 192;
  const bf16_t* Vp = (const bf16_t*)(ws + OFF_VT) + (size_t)(b * 16 + head) * 128 * S_;
  bf16x8 qf[12];
#pragma unroll
  for (int ks = 0; ks < 12; ++ks) qf[ks] = *(const bf16x8*)(Qp + lr * 192 + ks * 16 + lh * 8);
  f32x16 o[4];
#pragma unroll
  for (int d = 0; d < 4; ++d)
#pragma unroll
    for (int r = 0; r < 16; ++r) o[d][r] = 0.f;
  float m = -INFINITY, lsum = 0.f;
  u32x4 rk[6], rv[4];
  int koff[6];
#pragma unroll
  for (int i = 0; i < 6; ++i) { const int cidx = tid + 256 * i; const int row = cidx / 24; koff[i] = row * 200 + (cidx - row * 24) * 8; }
  const int vrow_ = tid >> 3, vkc = (tid & 7) * 8;
  const int vpos = (vkc & ~15) + ((vkc & 8) ? 4 : 0);
#pragma unroll
  for (int i = 0; i < 6; ++i) rk[i] = *(const u32x4*)(Kp + (size_t)(tid + 256 * i) * 8);
#pragma unroll
  for (int i = 0; i < 4; ++i) rv[i] = *(const u32x4*)(Vp + (size_t)(vrow_ + 32 * i) * S_ + vkc);
#pragma unroll 1
  for (int kt = 0; kt < 32; ++kt) {
    __syncthreads();
#pragma unroll
    for (int i = 0; i < 6; ++i) *(u32x4*)(sK + koff[i]) = rk[i];
#pragma unroll
    for (int i = 0; i < 4; ++i) { bf16_t* d = sV + (vrow_ + 32 * i) * 72 + vpos; *(u32x2*)d = (u32x2){rv[i][0], rv[i][1]}; *(u32x2*)(d + 8) = (u32x2){rv[i][2], rv[i][3]}; }
    __syncthreads();
    if (kt + 1 < 32) {
      const int key0 = (kt + 1) * 64;
#pragma unroll
      for (int i = 0; i < 6; ++i) rk[i] = *(const u32x4*)(Kp + (size_t)key0 * 192 + (size_t)(tid + 256 * i) * 8);
#pragma unroll
      for (int i = 0; i < 4; ++i) rv[i] = *(const u32x4*)(Vp + (size_t)(vrow_ + 32 * i) * S_ + key0 + vkc);
    }
    f32x16 s0, s1;
#pragma unroll
    for (int r = 0; r < 16; ++r) { s0[r] = 0.f; s1[r] = 0.f; }
    const bf16_t* kb0 = sK + lr * 200 + lh * 8; const bf16_t* kb1 = kb0 + 32 * 200;
#pragma unroll
    for (int ks = 0; ks < 12; ++ks) { const bf16x8 kf = *(const bf16x8*)(kb0 + ks * 16); s0 = MFMA32(kf, qf[ks], s0); }
    {
      float mx = fmaxf(fmaxf(s0[0], s0[1]), fmaxf(s0[2], s0[3]));
#pragma unroll
      for (int r = 4; r < 16; ++r) mx = fmaxf(mx, s0[r]);
      mx = fmaxf(mx, __shfl_xor(mx, 32));
      const float mn = fmaxf(m, mx);
      if (__builtin_amdgcn_ballot_w64(mx > m + 8.f) != 0) {
        const float alpha = __builtin_amdgcn_exp2f(m - mn); lsum *= alpha;
#pragma unroll
        for (int d = 0; d < 4; ++d)
#pragma unroll
          for (int r = 0; r < 16; ++r) o[d][r] *= alpha;
        m = mn;
      }
    }
#pragma unroll
    for (int ks = 0; ks < 12; ++ks) { const bf16x8 kf = *(const bf16x8*)(kb1 + ks * 16); s1 = MFMA32(kf, qf[ks], s1); }
    float psA = 0.f;
#pragma unroll
    for (int r = 0; r < 16; ++r) { const float e = __builtin_amdgcn_exp2f(s0[r] - m); s0[r] = e; psA += e; }
    {
      float mx = fmaxf(fmaxf(s1[0], s1[1]), fmaxf(s1[2], s1[3]));
#pragma unroll
      for (int r = 4; r < 16; ++r) mx = fmaxf(mx, s1[r]);
      mx = fmaxf(mx, __shfl_xor(mx, 32));
      const float mn = fmaxf(m, mx);
      if (__builtin_amdgcn_ballot_w64(mx > m + 8.f) != 0) {
        const float alpha = __builtin_amdgcn_exp2f(m - mn); lsum *= alpha; psA *= alpha;
#pragma unroll
        for (int r = 0; r < 16; ++r) s0[r] *= alpha;
#pragma unroll
        for (int d = 0; d < 4; ++d)
#pragma unroll
          for (int r = 0; r < 16; ++r) o[d][r] *= alpha;
        m = mn;
      }
    }
    lsum += psA;
    const bf16_t* vb = sV + lr * 72 + lh * 8;
#pragma unroll
    for (int sh = 0; sh < 2; ++sh) {
      const bf16x8 pf = pack8(s0[8 * sh + 0], s0[8 * sh + 1], s0[8 * sh + 2], s0[8 * sh + 3], s0[8 * sh + 4], s0[8 * sh + 5], s0[8 * sh + 6], s0[8 * sh + 7]);
#pragma unroll
      for (int d = 0; d < 4; ++d) { const bf16x8 af = *(const bf16x8*)(vb + d * 32 * 72 + sh * 16); o[d] = MFMA32(af, pf, o[d]); }
    }
    float psB = 0.f;
#pragma unroll
    for (int r = 0; r < 16; ++r) { const float e = __builtin_amdgcn_exp2f(s1[r] - m); s1[r] = e; psB += e; }
    lsum += psB;
#pragma unroll
    for (int sh = 0; sh < 2; ++sh) {
      const bf16x8 pf = pack8(s1[8 * sh + 0], s1[8 * sh + 1], s1[8 * sh + 2], s1[8 * sh + 3], s1[8 * sh + 4], s1[8 * sh + 5], s1[8 * sh + 6], s1[8 * sh + 7]);
#pragma unroll
      for (int d = 0; d < 4; ++d) { const bf16x8 af = *(const bf16x8*)(vb + d * 32 * 72 + 32 + sh * 16); o[d] = MFMA32(af, pf, o[d]); }
    }
  }
  const float lt = lsum + __shfl_xor(lsum, 32); const float inv = 1.f / lt;
  float ss = 0.f;
#pragma unroll
  for (int d = 0; d < 4; ++d)
#pragma unroll
    for (int r = 0; r < 16; ++r) { o[d][r] *= inv; ss += o[d][r] * o[d][r]; }
  ss += __shfl_xor(ss, 32);
  const float rstd = rsqrtf(ss * (1.f / 128.f) + 1e-6f);
  const int tt = b * S_ + qb * 128 + w * 32 + lr;
  bf16_t* mix = (bf16_t*)(ws + OFF_MIX) + (size_t)tt * 4096 + head * 128;
  const float* gn = p.attn_out_norm + head * 128;
#pragma unroll
  for (int d = 0; d < 4; ++d)
#pragma unroll
    for (int rg = 0; rg < 4; ++rg) {
      const int dd = d * 32 + 8 * rg + 4 * lh;
      float4 g = *(const float4*)(gn + dd); uint2 ov;
      ov.x = pack2(o[d][4 * rg + 0] * rstd * g.x, o[d][4 * rg + 1] * rstd * g.y); ov.y = pack2(o[d][4 * rg + 2] * rstd * g.z, o[d][4 * rg + 3] * rstd * g.w);
      *(uint2*)(mix + dd) = ov;
    }
}

__device__ __forceinline__ void ssd_out_tile(const Params& p, int tile, unsigned char* smem) {
  unsigned char* ws = p.ws;
  const int g = tile & 7, c = (tile >> 3) & 15, b = tile >> 7; const int t0 = b * S_ + c * 128;
  const int tid = opaque_tid(), lane = tid & 63, w = tid >> 6, lr = lane & 31, lh = lane >> 5;
  bf16_t* sC = (bf16_t*)smem;
  bf16_t* sB = sC + 128 * 136;
  bf16_t* sXT = sB;
  float* sAc = (float*)(sB + 64 * 132);
  float* sDt = sAc + 128;
  bf16_t* sH = (bf16_t*)(sDt + 128);
  const bf16_t* xc = (const bf16_t*)(ws + OFF_A);
  const bf16_t* proj = (const bf16_t*)(ws + OFF_B);
  __syncthreads();
#pragma unroll
  for (int i = 0; i < 8; ++i) {
    const int cidx = tid + 256 * i; const int row = cidx >> 4, nc = cidx & 15;
    *(uint4*)(sB + row * 136 + nc * 8) = *(const uint4*)(xc + (size_t)(t0 + row) * 4096 + 2048 + g * 128 + nc * 8);
    *(uint4*)(sC + row * 136 + nc * 8) = *(const uint4*)(xc + (size_t)(t0 + row) * 4096 + 3072 + g * 128 + nc * 8);
  }
  __syncthreads();
  const int l0 = 32 * w, lidx = l0 + lr;
  bf16x8 cfr[8];
#pragma unroll
  for (int ks = 0; ks < 8; ++ks) cfr[ks] = *(const bf16x8*)(sC + lidx * 136 + ks * 16 + lh * 8);
  f32x16 G[4];
#pragma unroll
  for (int st = 0; st < 4; ++st) {
#pragma unroll
    for (int r = 0; r < 16; ++r) G[st][r] = 0.f;
#pragma unroll
    for (int ks = 0; ks < 8; ++ks) {
      bf16x8 af = *(const bf16x8*)(sB + (st * 32 + lr) * 136 + ks * 16 + lh * 8);
      G[st] = MFMA32(af, cfr[ks], G[st]);
    }
  }
  const int tt = t0 + lidx;
  bf16_t* mixrow = (bf16_t*)(ws + OFF_MIX) + (size_t)tt * 4096 + 2048 + g * 256;
  float ssq = 0.f;
#pragma unroll 1
  for (int r = 0; r < 4; ++r) {
    const int hd = g * 4 + r;
    __syncthreads();
#pragma unroll
    for (int i = 0; i < 2; ++i) {
      const int item = tid + 256 * i; const int sp = item >> 3, pc = item & 7;
      uint4 v0 = *(const uint4*)(xc + (size_t)(t0 + 2 * sp) * 4096 + hd * 64 + pc * 8);
      uint4 v1 = *(const uint4*)(xc + (size_t)(t0 + 2 * sp + 1) * 4096 + hd * 64 + pc * 8);
      unsigned a0[4] = {v0.x, v0.y, v0.z, v0.w}, a1[4] = {v1.x, v1.y, v1.z, v1.w};
#pragma unroll
      for (int j = 0; j < 4; ++j) {
        *(unsigned*)(sXT + (pc * 8 + 2 * j) * 132 + 2 * sp) = (a0[j] & 0xffffu) | (a1[j] << 16);
        *(unsigned*)(sXT + (pc * 8 + 2 * j + 1) * 132 + 2 * sp) = (a0[j] >> 16) | (a1[j] & 0xffff0000u);
      }
    }
    f32x16 y[2];
#pragma unroll
    for (int pt = 0; pt < 2; ++pt)
#pragma unroll
      for (int rr = 0; rr < 16; ++rr) y[pt][rr] = 0.f;
#pragma unroll 1
    for (int dir = 0; dir < 2; ++dir) {
      const float* DT = (const float*)(ws + OFF_DT) + (size_t)dir * T_ * 32; const float* AC = (const float*)(ws + OFF_ACUM) + (size_t)dir * T_ * 32;
      const bf16_t* hin = (const bf16_t*)(ws + OFF_ST) + ((((size_t)(dir * 4 + b) * 16 + c) * 32 + hd) * 64) * 128;
      u32x4 hreg[4];
#pragma unroll
      for (int q = 0; q < 4; ++q) { const int cc = tid + 256 * q; hreg[q] = *(const u32x4*)(hin + (cc >> 4) * 128 + (cc & 15) * 8); }
      __syncthreads();
      if (tid < 128) { sAc[tid] = AC[(t0 + tid) * 32 + hd]; sDt[tid] = DT[(t0 + tid) * 32 + hd]; }
#pragma unroll
      for (int q = 0; q < 4; ++q) { const int cc = tid + 256 * q; *(u32x4*)(sH + (cc >> 4) * 136 + (cc & 15) * 8) = hreg[q]; }
      __syncthreads();
      const float acl = sAc[lidx];
      const int sgn = 1 - 2 * dir;
#pragma unroll
      for (int st = 0; st < 4; ++st)
#pragma unroll
        for (int sh = 0; sh < 2; ++sh) {
          const int sb0 = st * 32 + sh * 16 + lh * 4;
          float4 a0 = *(const float4*)(sAc + sb0), a1 = *(const float4*)(sAc + sb0 + 8);
          float4 d0 = *(const float4*)(sDt + sb0), d1 = *(const float4*)(sDt + sb0 + 8);
          float av[8] = {a0.x, a0.y, a0.z, a0.w, a1.x, a1.y, a1.z, a1.w};
          float dv[8] = {d0.x, d0.y, d0.z, d0.w, d1.x, d1.y, d1.z, d1.w};
          float mv[8];
#pragma unroll
          for (int j = 0; j < 8; ++j) {
            const int sidx = sb0 + (j & 3) + 8 * (j >> 2);
            const float ex = ((lidx - sidx) * sgn >= 0) ? (acl - av[j]) : -INFINITY;
            mv[j] = G[st][8 * sh + j] * (__expf(ex) * dv[j]);
          }
          bf16x8 mf = pack8(mv[0], mv[1], mv[2], mv[3], mv[4], mv[5], mv[6], mv[7]);
#pragma unroll
          for (int pt = 0; pt < 2; ++pt) {
            const bf16_t* xrow = sXT + (pt * 32 + lr) * 132 + sb0;
            bf16x8 af = mk8(*(const uint2*)xrow, *(const uint2*)(xrow + 8));
            y[pt] = MFMA32(af, mf, y[pt]);
          }
        }
      f32x16 yo[2];
#pragma unroll
      for (int pt = 0; pt < 2; ++pt)
#pragma unroll
        for (int rr = 0; rr < 16; ++rr) yo[pt][rr] = 0.f;
#pragma unroll
      for (int ks = 0; ks < 8; ++ks)
#pragma unroll
        for (int pt = 0; pt < 2; ++pt) {
          bf16x8 hf = *(const bf16x8*)(sH + (pt * 32 + lr) * 136 + ks * 16 + lh * 8);
          yo[pt] = MFMA32(hf, cfr[ks], yo[pt]);
        }
      const float el = expf(acl);
#pragma unroll
      for (int pt = 0; pt < 2; ++pt)
#pragma unroll
        for (int rr = 0; rr < 16; ++rr) y[pt][rr] += el * yo[pt][rr];
    }
    const float dsk = p.d_skip[hd];
#pragma unroll
    for (int pt = 0; pt < 2; ++pt)
#pragma unroll
      for (int rg = 0; rg < 4; ++rg) {
        const int pp = pt * 32 + 8 * rg + 4 * lh; const int ch = hd * 64 + pp;
        uint2 xv = *(const uint2*)(xc + (size_t)tt * 4096 + ch);
        uint2 zv = *(const uint2*)(proj + (size_t)tt * PJW + 1600 + ch);
        float xs4[4] = {bflo(xv.x), bfhi(xv.x), bflo(xv.y), bfhi(xv.y)};
        float zs4[4] = {bflo(zv.x), bfhi(zv.x), bflo(zv.y), bfhi(zv.y)};
        float yv[4];
#pragma unroll
        for (int j = 0; j < 4; ++j) { float v = y[pt][4 * rg + j] + dsk * xs4[j]; v *= zs4[j] / (1.f + __expf(-zs4[j])); yv[j] = v; ssq += v * v; }
        uint2 ov; ov.x = pack2(yv[0], yv[1]); ov.y = pack2(yv[2], yv[3]);
        *(uint2*)(mixrow + r * 64 + pp) = ov;
      }
  }
  ssq += __shfl_xor(ssq, 32);
  const float rstd = rsqrtf(ssq * (1.f / 256.f) + 1e-6f);
  __threadfence_block();
#pragma unroll
  for (int r = 0; r < 4; ++r)
#pragma unroll
    for (int pt = 0; pt < 2; ++pt)
#pragma unroll
      for (int rg = 0; rg < 4; ++rg) {
        const int pp = pt * 32 + 8 * rg + 4 * lh;
        uint2 v = *(uint2*)(mixrow + r * 64 + pp);
        float4 gn = *(const float4*)(p.ssm_out_norm + g * 256 + r * 64 + pp);
        uint2 ov; ov.x = pack2(bflo(v.x) * rstd * gn.x, bfhi(v.x) * rstd * gn.y); ov.y = pack2(bflo(v.y) * rstd * gn.z, bfhi(v.y) * rstd * gn.w);
        *(uint2*)(mixrow + r * 64 + pp) = ov;
      }
}

__device__ __forceinline__ void phase5(const Params& p, unsigned char* smem) {
  const int xcd = blockIdx.x & 7, local = blockIdx.x >> 3, nloc = gridDim.x >> 3;
  if (gridDim.x == 512) {
    const int conv_step = (local >= 32) ? 1 : 0;
#pragma unroll 1
    for (int step = 0; step < 3; ++step) {
      if (step == conv_step) fp8_convert_tiles(p, FP8_EARLY + blockIdx.x, 512);
      else {
        const int idx = local + 64 * ((step > conv_step) ? step - 1 : step);
        attn_tile(p, ((idx >> 6) * 8 + xcd) * 64 + (idx & 63), smem);
      }
    }
  } else {
    for (int idx = local; idx < 128; idx += nloc) attn_tile(p, ((idx >> 6) * 8 + xcd) * 64 + (idx & 63), smem);
  }
  for (int t = blockIdx.x; t < 512; t += gridDim.x) ssd_out_tile(p, t, smem);
}

__device__ __forceinline__ void phase6(const Params& p, unsigned char* smem) {
  unsigned char* ws = p.ws;
  EpiOut epi{p.x, p.out};
  const bf16_t* A = (const bf16_t*)(ws + OFF_MIX); const bf16_t* B = (const bf16_t*)(ws + OFF_WOUT);
  for_gemm_tiles(T_ / GBM, 32, [&](int mt, int nt) { gemm_tile<GBM, GNST>(A, 4096, B, 4096, 4096, mt * GBM, nt * 128, smem, epi); });
}

__device__ __forceinline__ void phase7(const Params& p, unsigned char* smem) {
  unsigned char* ws = p.ws; const int tid = opaque_tid(); const int lane = tid & 63, w = tid >> 6;
  for (int t = blockIdx.x; t < T_ / 4; t += gridDim.x) {
    const int row = t * 4 + w;
    rms_row_f32<4096>(p.out + (size_t)row * D_, p.norm_ffn, (bf16_t*)(ws + OFF_A) + (size_t)row * D_, lane);
  }
}

__device__ __forceinline__ void phase8(const Params& p, unsigned char* smem) {
  unsigned char* ws = p.ws;
  EpiBf16 epi{(bf16_t*)(ws + OFF_QP), 2048};
  const bf16_t* A = (const bf16_t*)(ws + OFF_A); const bf16_t* B = (const bf16_t*)(ws + OFF_WQ);
  for_gemm_tiles(T_ / GBM, 16, [&](int mt, int nt) { gemm_tile<GBM, GNST>(A, 4096, B, 4096, 4096, mt * GBM, nt * 128, smem, epi); });
}

__device__ __forceinline__ void phase9(const Params& p, unsigned char* smem) {
  unsigned char* ws = p.ws;
  EpiF32 epi{(float*)(ws + OFF_SC), 2048};
  const bf16_t* A = (const bf16_t*)(ws + OFF_QP); const bf16_t* B = (const bf16_t*)(ws + OFF_SK);
  for (int t = blockIdx.x; t < 1024; t += gridDim.x) {
    const int blk = t & 15, mt = t >> 4;
    gemm_tile<128, 4>(A + blk * 128, 2048, B, 128, 128, mt * 128, blk * 128, smem, epi);
  }
}

#define WAVE_LDS_FENCE() asm volatile("s_waitcnt lgkmcnt(0)" ::: "memory")
#define WAVE_LDS_FENCE() asm volatile("s_waitcnt lgkmcnt(0)" ::: "memory")
__device__ __forceinline__ void topk16_rank(const float a, const float b, int lane, unsigned* skey, float* tv, int* ti) {
  const unsigned ka = (fkey(a) & ~127u) | (unsigned)(127 - lane), kb = (fkey(b) & ~127u) | (unsigned)(63 - lane);
  unsigned T = 0u;
#pragma unroll
  for (int bit = 31; bit >= 0; --bit) {
    const unsigned c = T | (1u << bit);
    const int cnt = __builtin_popcountll(__builtin_amdgcn_ballot_w64(ka >= c)) + __builtin_popcountll(__builtin_amdgcn_ballot_w64(kb >= c));
    T = (cnt >= 16) ? c : T;
  }
  const bool sa = ka >= T, sb = kb >= T;
  const unsigned long long ma = __builtin_amdgcn_ballot_w64(sa), mb = __builtin_amdgcn_ballot_w64(sb);
  const int pa = (int)__builtin_amdgcn_mbcnt_hi((unsigned)(ma >> 32), __builtin_amdgcn_mbcnt_lo((unsigned)ma, 0u));
  const int pb = __builtin_popcountll(ma) + (int)__builtin_amdgcn_mbcnt_hi((unsigned)(mb >> 32), __builtin_amdgcn_mbcnt_lo((unsigned)mb, 0u));
  float* sval = (float*)(skey + 16); int* sidx = (int*)(skey + 32);
  if (sa) { skey[pa & 15] = ka; sval[pa & 15] = a; sidx[pa & 15] = lane; }
  if (sb) { skey[pb & 15] = kb; sval[pb & 15] = b; sidx[pb & 15] = lane + 64; }
  WAVE_LDS_FENCE();
  {
    const unsigned mk = skey[lane & 15]; const float mv = sval[lane & 15]; const int mi = sidx[lane & 15];
    int rank = 0;
#pragma unroll
    for (int j4 = 0; j4 < 4; ++j4) {
      const u32x4 x = *(const u32x4*)(skey + 4 * j4);
#pragma unroll
      for (int e = 0; e < 4; ++e) rank += (x[e] > mk) ? 1 : 0;
    }
    if (lane < 16) { tv[rank] = mv; ti[rank] = mi; }
  }
  WAVE_LDS_FENCE();
}

__device__ __forceinline__ void peer_fma(const u32x4 (&u)[4], const unsigned (&hvp)[32], float& dot) {
#pragma unroll
  for (int i = 0; i < 4; ++i)
#pragma unroll
    for (int q = 0; q < 4; ++q) {
      const int wd = (int)u[i][q];
      const f32x2_t lo = __builtin_amdgcn_cvt_pk_f32_fp8(wd, false), hi = __builtin_amdgcn_cvt_pk_f32_fp8(wd, true);
      const unsigned h0 = hvp[8 * i + 2 * q], h1 = hvp[8 * i + 2 * q + 1];
      dot += lo[0] * bflo(h0) + lo[1] * bfhi(h0) + hi[0] * bflo(h1) + hi[1] * bfhi(h1);
    }
}
__device__ __forceinline__ void peer_axpy(const u32x4 (&v)[4], float coef, float (&acc)[64]) {
#pragma unroll
  for (int i = 0; i < 4; ++i)
#pragma unroll
    for (int q = 0; q < 4; ++q) {
      const int wd = (int)v[i][q];
      const f32x2_t lo = __builtin_amdgcn_cvt_pk_f32_fp8(wd, false), hi = __builtin_amdgcn_cvt_pk_f32_fp8(wd, true);
      acc[16 * i + 4 * q] += coef * lo[0]; acc[16 * i + 4 * q + 1] += coef * lo[1]; acc[16 * i + 4 * q + 2] += coef * hi[0]; acc[16 * i + 4 * q + 3] += coef * hi[1];
    }
}

__device__ __forceinline__ void phase10(const Params& p, unsigned char* smem) {
  unsigned char* ws = p.ws; const int tid = opaque_tid(), lane = tid & 63, w = tid >> 6;
  unsigned char* wb = smem + w * 4096;
  unsigned* skey = (unsigned*)wb;
  float* tv = (float*)(wb + 512);
  int* ti = (int*)(wb + 640);
  float* cs = (float*)(wb + 768);
  int* cf = (int*)(wb + 1024);
  float* ts = (float*)(wb + 1280);
  int* te = (int*)(wb + 1344);
  int* s_idx = (int*)(wb + 1536);
  float* s_gate = (float*)(wb + 2048);
  const float* SC = (const float*)(ws + OFF_SC); const bf16_t* hn = (const bf16_t*)(ws + OFF_A);
  const unsigned char* EU = ws + OFF_EU8; const unsigned char* EV = ws + OFF_EV8;
  const float* SU = (const float*)(ws + OFF_ESC); const float* SV = SU + 16384;
  int ci = 0, cj = 0;
  { int cnt = 0;
#pragma unroll
    for (int i = 0; i < 16; ++i) { const int n = 16 / (i + 1); if (lane >= cnt && lane < cnt + n) { ci = i; cj = lane - cnt; } cnt += n; } }
  for (int t = blockIdx.x; t < T_ / 4; t += gridDim.x) {
    const int tt = t * 4 + w;
    WAVE_LDS_FENCE();
    float sca[16], scb[16];
#pragma unroll
    for (int l = 0; l < 16; ++l) { sca[l] = SC[(size_t)tt * 2048 + l * 128 + lane]; scb[l] = SC[(size_t)tt * 2048 + l * 128 + 64 + lane]; }
#pragma unroll
    for (int h = 0; h < 8; ++h) {
      topk16_rank(sca[2 * h], scb[2 * h], lane, skey, tv, ti);
      topk16_rank(sca[2 * h + 1], scb[2 * h + 1], lane, skey, tv + 16, ti + 16);
      const float c = (lane < 50) ? tv[ci] + tv[16 + cj] : -INFINITY; const int fl = ci * 16 + cj;
      cs[lane] = c; cf[lane] = fl;
      WAVE_LDS_FENCE();
      int rank = 0;
#pragma unroll
      for (int l4 = 0; l4 < 13; ++l4) {
        const float4 c4 = *(const float4*)(cs + 4 * l4); const int4 f4 = *(const int4*)(cf + 4 * l4);
        rank += (c4.x > c || (c4.x == c && f4.x < fl)) ? 1 : 0; rank += (c4.y > c || (c4.y == c && f4.y < fl)) ? 1 : 0;
        rank += (c4.z > c || (c4.z == c && f4.z < fl)) ? 1 : 0; rank += (c4.w > c || (c4.w == c && f4.w < fl)) ? 1 : 0;
      }
      if (lane < 50 && rank < 16) { ts[rank] = c; te[rank] = ti[ci] * 128 + ti[16 + cj]; }
      WAVE_LDS_FENCE();
      const float tsv = ts[lane & 15]; const float ex = expf(tsv - ts[0]);
      float sum = ex; sum += __shfl_xor(sum, 8); sum += __shfl_xor(sum, 4); sum += __shfl_xor(sum, 2); sum += __shfl_xor(sum, 1);
      if (lane < 16) { s_idx[h * 16 + lane] = te[lane]; s_gate[h * 16 + lane] = ex / sum; }
    }
    WAVE_LDS_FENCE();
    unsigned hv[32]; float acc[64];
#pragma unroll
    for (int i = 0; i < 4; ++i) {
      const u32x4 h0 = *(const u32x4*)(hn + (size_t)tt * 4096 + 16 * (lane + 64 * i)), h1 = *(const u32x4*)(hn + (size_t)tt * 4096 + 16 * (lane + 64 * i) + 8);
#pragma unroll
      for (int q = 0; q < 4; ++q) { hv[8 * i + q] = h0[q]; hv[8 * i + 4 + q] = h1[q]; }
    }
#pragma unroll
    for (int i = 0; i < 64; ++i) acc[i] = 0.f;
    u32x4 ua[4], va[4], ub[4], vb[4];
    { const int idx = __builtin_amdgcn_readfirstlane(s_idx[0]);
#pragma unroll
      for (int i = 0; i < 4; ++i) { ua[i] = *(const u32x4*)(EU + (size_t)idx * 4096 + 16 * (lane + 64 * i)); va[i] = *(const u32x4*)(EV + (size_t)idx * 4096 + 16 * (lane + 64 * i)); } }
#pragma unroll 1
    for (int k = 0; k < 128; k += 2) {
      const int idxb = __builtin_amdgcn_readfirstlane(s_idx[k + 1]);
#pragma unroll
      for (int i = 0; i < 4; ++i) { ub[i] = *(const u32x4*)(EU + (size_t)idxb * 4096 + 16 * (lane + 64 * i)); vb[i] = *(const u32x4*)(EV + (size_t)idxb * 4096 + 16 * (lane + 64 * i)); }
      { const int idx = __builtin_amdgcn_readfirstlane(s_idx[k]); const float gt = s_gate[k];
        float dot = 0.f; peer_fma(ua, hv, dot);
        dot = wave_sum_fast(dot) * SU[idx];
        const float act = dot / (1.f + __expf(-1.5957691216057308f * (dot + 0.044715f * dot * dot * dot)));
        peer_axpy(va, gt * act * SV[idx], acc); }
      if (k + 2 < 128) {
        const int idxa = __builtin_amdgcn_readfirstlane(s_idx[k + 2]);
#pragma unroll
        for (int i = 0; i < 4; ++i) { ua[i] = *(const u32x4*)(EU + (size_t)idxa * 4096 + 16 * (lane + 64 * i)); va[i] = *(const u32x4*)(EV + (size_t)idxa * 4096 + 16 * (lane + 64 * i)); }
      }
      { const float gt = s_gate[k + 1];
        float dot = 0.f; peer_fma(ub, hv, dot);
        dot = wave_sum_fast(dot) * SU[idxb];
        const float act = dot / (1.f + __expf(-1.5957691216057308f * (dot + 0.044715f * dot * dot * dot)));
        peer_axpy(vb, gt * act * SV[idxb], acc); }
    }
    float4* op = (float4*)(p.out + (size_t)tt * D_);
#pragma unroll
    for (int i = 0; i < 4; ++i)
#pragma unroll
      for (int q = 0; q < 4; ++q) {
        float4 o = op[(lane + 64 * i) * 4 + q];
        o.x += acc[16 * i + 4 * q]; o.y += acc[16 * i + 4 * q + 1]; o.z += acc[16 * i + 4 * q + 2]; o.w += acc[16 * i + 4 * q + 3];
        op[(lane + 64 * i) * 4 + q] = o;
      }
  }
}


#define XB_TMO      128
#define XB_XCNT(j)  (256  + 64 * (j))
#define XB_XSUB(j)  (1280 + 64 * (j))
#define XB_XGEN(j)  (2304 + 64 * (j))
#define XB_TOP      3328
#define XB_TOPGEN   3392
#define XB_SPIN_CAP (1u << 18)
__device__ __forceinline__ unsigned xb_ld(unsigned* q)              { return __hip_atomic_load(q, __ATOMIC_RELAXED, __HIP_MEMORY_SCOPE_AGENT); }
__device__ __forceinline__ unsigned xb_add(unsigned* q, unsigned v) { return __hip_atomic_fetch_add(q, v, __ATOMIC_RELAXED, __HIP_MEMORY_SCOPE_AGENT); }
__device__ __forceinline__ unsigned xb_xcc_id() { return (unsigned)__builtin_amdgcn_s_getreg((3 << 11) | 20) & 0xFu; }
#define XB_SPIN(cond, bar) do { unsigned _sp = 0; while (cond) { __builtin_amdgcn_s_sleep(1); \
    if ((++_sp & 255u) == 0u) { if (xb_ld(&(bar)[XB_TMO])) break; if (_sp > XB_SPIN_CAP) { atomicAdd(&(bar)[XB_TMO], 1u); break; } } } } while (0)
struct XcdBarrier { unsigned* bar; unsigned x; volatile unsigned* st; };
__device__ __forceinline__ XcdBarrier xcd_barrier_post(unsigned* bar, volatile unsigned* st) {
  XcdBarrier b; b.bar = bar; b.x = xb_xcc_id(); b.st = st;
  if (threadIdx.x == 0) (void)xb_add(&bar[XB_XCNT(b.x)], 1u);
  return b;
}
__device__ __forceinline__ void xcd_barrier_complete(unsigned* bar, unsigned x, unsigned& nloc, unsigned& nx) {
  const unsigned G = gridDim.x * gridDim.y * gridDim.z;
  unsigned sum, cnt, mine, sp = 0u;
  for (;;) {
    sum = 0u; cnt = 0u; mine = 0u;
#pragma unroll
    for (unsigned j = 0; j < 16; ++j) { const unsigned c = xb_ld(&bar[XB_XCNT(j)]); sum += c; cnt += (c > 0u) ? 1u : 0u; mine = (j == x) ? c : mine; }
    if (sum == G) break;
    __builtin_amdgcn_s_sleep(1);
    if ((++sp & 255u) == 0u) { if (xb_ld(&bar[XB_TMO])) break; if (sp > XB_SPIN_CAP) { atomicAdd(&bar[XB_TMO], 1u); break; } }
  }
  nloc = mine > 0u ? mine : 1u; nx = cnt > 0u ? cnt : 1u;
}
__device__ __forceinline__ void xcd_barrier(const XcdBarrier& b) {
  asm volatile("s_waitcnt vmcnt(0)" ::: "memory");
  __syncthreads();
  if (threadIdx.x == 0) {
    unsigned* bar = b.bar;
    __builtin_amdgcn_s_waitcnt(0);
    unsigned nloc = b.st[0], nx = b.st[1];
    if (nloc == 0u) { xcd_barrier_complete(bar, b.x, nloc, nx); b.st[0] = nloc; b.st[1] = nx; }
    const unsigned old = xb_add(&bar[XB_XSUB(b.x)], 1u);
    const unsigned gen = old / nloc;
    if (old + 1u == (gen + 1u) * nloc) {
      __builtin_amdgcn_fence(__ATOMIC_RELEASE, "agent");
      asm volatile("s_waitcnt vmcnt(0)" ::: "memory");
      const unsigned og = xb_add(&bar[XB_TOP], 1u);
      const unsigned tg = og / nx;
      if (og + 1u == (tg + 1u) * nx) xb_add(&bar[XB_TOPGEN], 1u);
      else XB_SPIN(xb_ld(&bar[XB_TOPGEN]) == tg, bar);
      __builtin_amdgcn_fence(__ATOMIC_ACQUIRE, "agent");
      xb_add(&bar[XB_XGEN(b.x)], 1u);
      asm volatile("s_waitcnt vmcnt(0)" ::: "memory");
    } else {
      XB_SPIN(xb_ld(&bar[XB_XGEN(b.x)]) == gen, bar);
      __builtin_amdgcn_fence(__ATOMIC_ACQUIRE, "agent");
      asm volatile("s_waitcnt vmcnt(0)" ::: "memory");
    }
  }
  __syncthreads();
}

#ifndef PROBE_DUP
#define PROBE_DUP 0
#endif
#define RUN_PHASE(n) if (lo <= n && n < hi) { if (n > lo) xcd_barrier(xb); phase##n(p, smem); }
__global__ void __launch_bounds__(256, 2) fwd_megakernel(Params p) {
  extern __shared__ __attribute__((aligned(16))) unsigned char smem[];
  const int lo = (int)p.ph_lo, hi = (int)p.ph_hi;
  volatile unsigned* st = (volatile unsigned*)(smem + LDS_BYTES - 16);
  if (threadIdx.x < 2) st[threadIdx.x] = 0u;
  __syncthreads();
  XcdBarrier xb = xcd_barrier_post((unsigned*)(p.ws + OFF_BAR), st);
  if (hi > 1000) cg::this_grid().sync();
  RUN_PHASE(0) RUN_PHASE(1) RUN_PHASE(2) RUN_PHASE(3) RUN_PHASE(4) RUN_PHASE(5)
  RUN_PHASE(6) RUN_PHASE(7) RUN_PHASE(8) RUN_PHASE(9) RUN_PHASE(10)
}

extern "C" void kernel_launch(void* const* d_in, const int* in_sizes, int n_in, void* d_out, int out_size, void* d_ws, size_t ws_size,
                              hipStream_t stream) {
  static int grid_blocks = 0;
  if (!grid_blocks) {
    if (ws_size < OFF_END) { fprintf(stderr, "kernel_launch: workspace too small (%zu < %zu)\n", ws_size, (size_t)OFF_END); grid_blocks = -1; return; }
    int dev = 0, cus = 0, per_cu = 0;
    hipGetDevice(&dev);
    hipDeviceGetAttribute(&cus, hipDeviceAttributeMultiprocessorCount, dev);
    if (hipFuncSetAttribute((const void*)fwd_megakernel, hipFuncAttributeMaxDynamicSharedMemorySize, LDS_BYTES) != hipSuccess) { fprintf(stderr, "kernel_launch: hipFuncSetAttribute failed\n"); grid_blocks = -1; return; }
    hipOccupancyMaxActiveBlocksPerMultiprocessor(&per_cu, (const void*)fwd_megakernel, 256, LDS_BYTES);
    if (per_cu < 1) { fprintf(stderr, "kernel_launch: occupancy query returned %d\n", per_cu); per_cu = 1; }
    if (per_cu > 2) per_cu = 2;
    grid_blocks = cus * per_cu;
  }
  if (grid_blocks < 0) return;
  Params p{};
  p.x = (const float*)d_in[0]; p.pos = (const int*)d_in[1]; p.norm_mix = (const float*)d_in[2]; p.w_in = (const float*)d_in[3];
  p.q_a_norm = (const float*)d_in[4]; p.w_uq = (const float*)d_in[5]; p.kv_a_norm = (const float*)d_in[6]; p.w_ukv = (const float*)d_in[7];
  p.q_norm = (const float*)d_in[8]; p.k_norm = (const float*)d_in[9]; p.attn_out_norm = (const float*)d_in[10]; p.conv_w = (const float*)d_in[11];
  p.conv_b = (const float*)d_in[12]; p.a_log_f = (const float*)d_in[13]; p.a_log_b = (const float*)d_in[14]; p.dt_bias_f = (const float*)d_in[15];
  p.dt_bias_b = (const float*)d_in[16]; p.d_skip = (const float*)d_in[17]; p.ssm_out_norm = (const float*)d_in[18]; p.w_out = (const float*)d_in[19];
  p.norm_ffn = (const float*)d_in[20]; p.w_query = (const float*)d_in[21]; p.sub_keys = (const float*)d_in[22]; p.expert_u = (const float*)d_in[23];
  p.expert_v = (const float*)d_in[24];
  p.out = (float*)d_out; p.ws = (unsigned char*)d_ws;
#if ONE_LAUNCH
  p.ph_lo = 0; p.ph_hi = NPHASE;
  if (hipMemsetAsync((unsigned char*)d_ws + OFF_BAR, 0, BAR_BYTES, stream) != hipSuccess) { fprintf(stderr, "kernel_launch: hipMemsetAsync failed\n"); return; }
  void* args[] = {&p};
  hipError_t e = hipLaunchCooperativeKernel((const void*)fwd_megakernel, dim3(grid_blocks), dim3(256), args, LDS_BYTES, stream);
  if (e != hipSuccess) fprintf(stderr, "cooperative launch failed: %s (grid %d)\n", hipGetErrorString(e), grid_blocks);
#else
  for (int ph = 0; ph < NPHASE; ++ph) {
    p.ph_lo = ph; p.ph_hi = ph + 1;
    hipLaunchKernelGGL(fwd_megakernel, dim3(grid_blocks), dim3(256), LDS_BYTES, stream, p);
  }
#endif
}
```

```cpp
#include <hip/hip_runtime.h>
#include <hip/hip_cooperative_groups.h>
#include <cstdio>
#include <cstdint>
namespace cg = cooperative_groups;

typedef unsigned short bf16_t;
typedef __attribute__((ext_vector_type(8))) short bf16x8;
typedef __attribute__((ext_vector_type(4))) float f32x4;
typedef __attribute__((ext_vector_type(16))) float f32x16;
typedef __attribute__((ext_vector_type(4))) unsigned u32x4;
typedef __attribute__((ext_vector_type(2))) unsigned u32x2;

#ifndef ONE_LAUNCH
#define ONE_LAUNCH 1
#endif

constexpr int T_ = 8192, S_ = 2048, D_ = 4096, PJW = 7744;
constexpr int NPHASE = 11;
constexpr int FP8_EARLY = 3328;
constexpr int LDS_BYTES = 73728 + 256;
#ifndef GBM
#define GBM 256
#endif
#ifndef GNST
#define GNST 3
#endif

constexpr size_t SZ_WIN = (size_t)7808 * 4096 * 2, SZ_WUQ = (size_t)3072 * 1024 * 2, SZ_WUKV = (size_t)4096 * 512 * 2,
                 SZ_WOUT = (size_t)4096 * 4096 * 2, SZ_WQ = (size_t)2048 * 4096 * 2, SZ_SK = (size_t)16 * 128 * 128 * 2;
constexpr size_t OFF_WIN = 0, OFF_WUQ = OFF_WIN + SZ_WIN, OFF_WUKV = OFF_WUQ + SZ_WUQ, OFF_WOUT = OFF_WUKV + SZ_WUKV,
                 OFF_WQ = OFF_WOUT + SZ_WOUT, OFF_SK = OFF_WQ + SZ_WQ;
constexpr size_t OFF_A = OFF_SK + SZ_SK;
constexpr size_t OFF_B = OFF_A + (size_t)T_ * 4096 * 2;
constexpr size_t OFF_DTRAW = OFF_B + (size_t)T_ * PJW * 2;
constexpr size_t OFF_DT = OFF_DTRAW + (size_t)T_ * 64 * 4;
constexpr size_t OFF_ACUM = OFF_DT + (size_t)2 * T_ * 32 * 4;
constexpr size_t OFF_CQN = OFF_ACUM + (size_t)2 * T_ * 32 * 4;
constexpr size_t OFF_CKVN = OFF_CQN + (size_t)T_ * 1024 * 2;
constexpr size_t OFF_QRAW = OFF_CKVN + (size_t)T_ * 512 * 2;
constexpr size_t OFF_KVRAW = OFF_QRAW + (size_t)T_ * 3072 * 2;
constexpr size_t OFF_ST = OFF_KVRAW + (size_t)T_ * 4096 * 2;
constexpr size_t OFF_Q = OFF_ST + (size_t)2 * 4 * 16 * 32 * 64 * 128 * 2;
constexpr size_t OFF_K = OFF_Q + (size_t)4 * 16 * 2048 * 192 * 2;
constexpr size_t OFF_VT = OFF_K + (size_t)4 * 16 * 2048 * 192 * 2;
constexpr size_t OFF_EU8 = OFF_VT + (size_t)4 * 16 * 128 * 2048 * 2;
constexpr size_t OFF_EV8 = OFF_EU8 + (size_t)16384 * 4096;
constexpr size_t OFF_ESC = OFF_EV8 + (size_t)16384 * 4096;
constexpr size_t OFF_BAR = OFF_ESC + (size_t)2 * 16384 * 4;
constexpr size_t BAR_BYTES = 3456 * 4;
constexpr size_t OFF_END = OFF_BAR + 16384;
constexpr size_t OFF_QP = OFF_B;
constexpr size_t OFF_SC = OFF_B + (size_t)T_ * 2048 * 2;
constexpr size_t OFF_MIX = OFF_QRAW;

struct Params {
  const float* x; const int* pos; const float* norm_mix; const float* w_in; const float* q_a_norm; const float* w_uq;
  const float* kv_a_norm; const float* w_ukv; const float* q_norm; const float* k_norm; const float* attn_out_norm;
  const float* conv_w; const float* conv_b; const float* a_log_f; const float* a_log_b; const float* dt_bias_f; const float* dt_bias_b;
  const float* d_skip; const float* ssm_out_norm; const float* w_out; const float* norm_ffn; const float* w_query; const float* sub_keys;
  const float* expert_u; const float* expert_v;
  float* out; unsigned char* ws;
  long long ph_lo, ph_hi;
};

typedef __bf16 hwbf16x2 __attribute__((ext_vector_type(2)));
typedef float hwf32x2 __attribute__((ext_vector_type(2)));
__device__ __forceinline__ unsigned short f2bf(float f) { return __builtin_bit_cast(unsigned short, (__bf16)f); }
__device__ __forceinline__ float bf2f(unsigned short h) { return __uint_as_float(((unsigned)h) << 16); }
__device__ __forceinline__ unsigned pack2(float a, float b) { hwf32x2 f = {a, b}; return __builtin_bit_cast(unsigned, __builtin_convertvector(f, hwbf16x2)); }
__device__ __forceinline__ float bflo(unsigned u) { return __uint_as_float(u << 16); }
__device__ __forceinline__ float bfhi(unsigned u) { return __uint_as_float(u & 0xffff0000u); }
union U4B8 { uint4 u; bf16x8 v; };
__device__ __forceinline__ bf16x8 pack8(float a0, float a1, float a2, float a3, float a4, float a5, float a6, float a7) {
  U4B8 x; x.u = make_uint4(pack2(a0, a1), pack2(a2, a3), pack2(a4, a5), pack2(a6, a7)); return x.v;
}
__device__ __forceinline__ bf16x8 mk8(uint2 lo, uint2 hi) { U4B8 x; x.u = make_uint4(lo.x, lo.y, hi.x, hi.y); return x.v; }
__device__ __forceinline__ float wave_sum(float v) {
#pragma unroll
  for (int o = 32; o; o >>= 1) v += __shfl_xor(v, o);
  return v;
}
__device__ __forceinline__ void wave_argmax(float& v, int& i) {
#pragma unroll
  for (int o = 32; o; o >>= 1) {
    float ov = __shfl_xor(v, o); int oi = __shfl_xor(i, o);
    if (ov > v || (ov == v && oi < i)) { v = ov; i = oi; }
  }
}
__device__ __forceinline__ int opaque_tid() { int t = threadIdx.x; asm volatile("" : "+v"(t)); return t; }
__device__ __forceinline__ unsigned char* opaque_ptr(unsigned char* q) { asm volatile("" : "+s"(q)); return q; }
typedef float f32x2_t __attribute__((ext_vector_type(2)));
template <int CTRL> __device__ __forceinline__ float dppx(float v) { return __int_as_float(__builtin_amdgcn_update_dpp(0, __float_as_int(v), CTRL, 0xF, 0xF, true)); }
__device__ __forceinline__ float wave_sum_fast(float v) {
  v += dppx<0xB1>(v); v += dppx<0x4E>(v); v += dppx<0x141>(v); v += dppx<0x140>(v);
  const int iv = __float_as_int(v);
  return __int_as_float(__builtin_amdgcn_readlane(iv, 0)) + __int_as_float(__builtin_amdgcn_readlane(iv, 16)) +
         __int_as_float(__builtin_amdgcn_readlane(iv, 32)) + __int_as_float(__builtin_amdgcn_readlane(iv, 48));
}
__device__ __forceinline__ unsigned fkey(float f) { unsigned u = __float_as_uint(f); return (u & 0x80000000u) ? ~u : (u | 0x80000000u); }
__device__ __forceinline__ void fp8_row(const float* __restrict__ src, unsigned char* __restrict__ dst, float* __restrict__ scale_out, int lane) {
  float4 v[16]; float amax = 0.f;
#pragma unroll
  for (int j = 0; j < 16; ++j) {
    float4 t = ((const float4*)src)[lane + 64 * j]; v[j] = t;
    amax = fmaxf(amax, fmaxf(fmaxf(fabsf(t.x), fabsf(t.y)), fmaxf(fabsf(t.z), fabsf(t.w))));
  }
#pragma unroll
  for (int o = 32; o; o >>= 1) amax = fmaxf(amax, __shfl_xor(amax, o));
  const float sc = amax > 0.f ? 256.f / amax : 1.f;
  if (lane == 0) *scale_out = amax > 0.f ? amax * (1.f / 256.f) : 1.f;
#pragma unroll
  for (int j = 0; j < 16; ++j) {
    const float4 t = v[j];
    int wd = __builtin_amdgcn_cvt_pk_fp8_f32(t.x * sc, t.y * sc, 0, false);
    wd = __builtin_amdgcn_cvt_pk_fp8_f32(t.z * sc, t.w * sc, wd, true);
    ((unsigned*)dst)[lane + 64 * j] = (unsigned)wd;
  }
}
#define MFMA16(a, b, c) __builtin_amdgcn_mfma_f32_16x16x32_bf16(a, b, c, 0, 0, 0)
#define MFMA32(a, b, c) __builtin_amdgcn_mfma_f32_32x32x16_bf16(a, b, c, 0, 0, 0)

__device__ __forceinline__ void transpose_tile(const float* __restrict__ W, int K, int N, bf16_t* __restrict__ Wt, int tile, float* sm) {
  const int ntn = N >> 7; const int tk = tile / ntn, tn = tile - tk * ntn; const int k0 = tk << 6, n0 = tn << 7; const int tid = opaque_tid();
  float4 v[8];
#pragma unroll
  for (int i = 0; i < 8; ++i) v[i] = *(const float4*)(W + (size_t)(k0 + (tid >> 5) + 8 * i) * N + n0 + (tid & 31) * 4);
#pragma unroll
  for (int i = 0; i < 8; ++i) { float* d = sm + ((tid >> 5) + 8 * i) * 129 + (tid & 31) * 4; d[0] = v[i].x; d[1] = v[i].y; d[2] = v[i].z; d[3] = v[i].w; }
  __syncthreads();
#pragma unroll
  for (int i = 0; i < 4; ++i) {
    const int n = (tid >> 3) + 32 * i, kc = tid & 7; const float* s = sm + (kc * 8) * 129 + n;
    uint4 o; o.x = pack2(s[0], s[129]); o.y = pack2(s[258], s[387]); o.z = pack2(s[516], s[645]); o.w = pack2(s[774], s[903]);
    *(uint4*)(Wt + (size_t)(n0 + n) * K + k0 + kc * 8) = o;
  }
  __syncthreads();
}

template <int N>
__device__ __forceinline__ void rms_row_f32(const float* __restrict__ in, const float* __restrict__ gain, bf16_t* __restrict__ out, int lane) {
  constexpr int C = N / 256; float4 v[C]; float ss = 0.f;
#pragma unroll
  for (int i = 0; i < C; ++i) { v[i] = ((const float4*)in)[lane + 64 * i]; ss += v[i].x * v[i].x + v[i].y * v[i].y + v[i].z * v[i].z + v[i].w * v[i].w; }
  ss = wave_sum(ss); const float r = rsqrtf(ss * (1.f / N) + 1e-6f);
#pragma unroll
  for (int i = 0; i < C; ++i) {
    float4 g = ((const float4*)gain)[lane + 64 * i]; uint2 o;
    o.x = pack2(v[i].x * r * g.x, v[i].y * r * g.y); o.y = pack2(v[i].z * r * g.z, v[i].w * r * g.w);
    ((uint2*)out)[lane + 64 * i] = o;
  }
}
template <int N>
__device__ __forceinline__ void rms_row_bf16(const bf16_t* __restrict__ in, const float* __restrict__ gain, bf16_t* __restrict__ out, int lane) {
  constexpr int C = N / 256; uint2 v[C]; float ss = 0.f;
#pragma unroll
  for (int i = 0; i < C; ++i) { v[i] = ((const uint2*)in)[lane + 64 * i]; float a = bflo(v[i].x), b = bfhi(v[i].x), c = bflo(v[i].y), d = bfhi(v[i].y); ss += a * a + b * b + c * c + d * d; }
  ss = wave_sum(ss); const float r = rsqrtf(ss * (1.f / N) + 1e-6f);
#pragma unroll
  for (int i = 0; i < C; ++i) {
    float4 g = ((const float4*)gain)[lane + 64 * i]; uint2 o;
    o.x = pack2(bflo(v[i].x) * r * g.x, bfhi(v[i].x) * r * g.y); o.y = pack2(bflo(v[i].y) * r * g.z, bfhi(v[i].y) * r * g.w);
    ((uint2*)out)[lane + 64 * i] = o;
  }
}

#define GEMM_WAITV(n) asm volatile("s_waitcnt vmcnt(" #n ")" ::: "memory")
#define GEMM_RAWBAR() do { asm volatile("s_waitcnt lgkmcnt(0)" ::: "memory"); __builtin_amdgcn_s_barrier(); } while (0)
template <int BM, int NST, class Epi>
__device__ __forceinline__ void gemm_tile(const bf16_t* __restrict__ A, int lda, const bf16_t* __restrict__ B, int ldb, int K, int m0, int n0,
                                          unsigned char* smem, const Epi& epi) {
  constexpr int MI = BM / 32, NA = BM / 64, NV = NA + 2, D = NST - 1, STAGE_EL = (BM + 128) * 32;
  static_assert(NST == 3 || NST == 4, "ring depth");
  bf16_t* ring = (bf16_t*)smem;
  const int tid = opaque_tid(), lane = tid & 63, w = __builtin_amdgcn_readfirstlane(tid >> 6), wm = w >> 1, wn = w & 1;
  f32x4 acc[MI][4];
#pragma unroll
  for (int i = 0; i < MI; ++i)
#pragma unroll
    for (int j = 0; j < 4; ++j) acc[i][j] = (f32x4){0.f, 0.f, 0.f, 0.f};
  const int srow = tid >> 2, slc = (tid & 3) ^ ((tid >> 4) & 3);
  const bf16_t* Ag = A + (size_t)(m0 + srow) * lda + slc * 8;
  const bf16_t* Bg = B + (size_t)(n0 + srow) * ldb + slc * 8;
  const int nk = K >> 5;
#define GEMM_ISSUE(st, k0)                                                                                                     \
  do { bf16_t* sa_ = ring + (st) * STAGE_EL; bf16_t* sb_ = sa_ + BM * 32;                                                      \
    _Pragma("unroll") for (int i = 0; i < NA; ++i)                                                                             \
      __builtin_amdgcn_global_load_lds((const unsigned*)(Ag + (size_t)(64 * i) * lda + (k0)), (unsigned*)(sa_ + (i * 256 + w * 64) * 8), 16, 0, 0); \
    _Pragma("unroll") for (int i = 0; i < 2; ++i)                                                                              \
      __builtin_amdgcn_global_load_lds((const unsigned*)(Bg + (size_t)(64 * i) * ldb + (k0)), (unsigned*)(sb_ + (i * 256 + w * 64) * 8), 16, 0, 0); \
  } while (0)
  GEMM_ISSUE(0, 0);
  if (nk > 1) GEMM_ISSUE(1, 32);
  if (D >= 3 && nk > 2) GEMM_ISSUE(2, 64);
  const int fr = lane & 15, fq = lane >> 4;
  const int foff = fr * 32 + ((fq ^ ((fr >> 2) & 3)) * 8);
  int st = 0, stn = D % NST;
  for (int kt = 0; kt < nk; ++kt) {
    const int rem = min(D - 1, nk - 1 - kt);
    if (rem >= 2) { if (NV == 4) GEMM_WAITV(8); else GEMM_WAITV(12); }
    else if (rem == 1) { if (NV == 4) GEMM_WAITV(4); else GEMM_WAITV(6); }
    else GEMM_WAITV(0);
    GEMM_RAWBAR();
    const bf16_t* a_ = ring + st * STAGE_EL + (wm * (BM / 2)) * 32 + foff;
    const bf16_t* b_ = ring + st * STAGE_EL + BM * 32 + (wn * 64) * 32 + foff;
    bf16x8 af[MI], bfr[4];
#pragma unroll
    for (int j = 0; j < 4; ++j) bfr[j] = *(const bf16x8*)(b_ + j * 16 * 32);
#pragma unroll
    for (int i = 0; i < MI; ++i) af[i] = *(const bf16x8*)(a_ + i * 16 * 32);
    __builtin_amdgcn_sched_barrier(0);
    if (kt + D < nk) {
      bf16_t* sa_ = ring + stn * STAGE_EL; bf16_t* sb_ = sa_ + BM * 32; const int k0n = (kt + D) << 5;
#pragma unroll
      for (int i = 0; i < MI; ++i) {
#pragma unroll
        for (int j = 0; j < 4; ++j) acc[i][j] = MFMA16(af[i], bfr[j], acc[i][j]);
        if (i < NA) __builtin_amdgcn_global_load_lds((const unsigned*)(Ag + (size_t)(64 * i) * lda + k0n), (unsigned*)(sa_ + (i * 256 + w * 64) * 8), 16, 0, 0);
        else if (i < NV) __builtin_amdgcn_global_load_lds((const unsigned*)(Bg + (size_t)(64 * (i - NA)) * ldb + k0n), (unsigned*)(sb_ + ((i - NA) * 256 + w * 64) * 8), 16, 0, 0);
        __builtin_amdgcn_sched_barrier(0);
      }
    } else {
#pragma unroll
      for (int i = 0; i < MI; ++i)
#pragma unroll
        for (int j = 0; j < 4; ++j) acc[i][j] = MFMA16(af[i], bfr[j], acc[i][j]);
    }
    st = (st + 1 == NST) ? 0 : st + 1; stn = (stn + 1 == NST) ? 0 : stn + 1;
  }
  GEMM_RAWBAR();
#undef GEMM_ISSUE
  {
    float* stg = (float*)(smem + w * 18432);
    constexpr int SSTR = 68;
#pragma unroll
    for (int h = 0; h < MI / 4; ++h) {
#pragma unroll
      for (int i4 = 0; i4 < 4; ++i4)
#pragma unroll
        for (int j = 0; j < 4; ++j)
#pragma unroll
          for (int r = 0; r < 4; ++r) stg[(i4 * 16 + (lane >> 4) * 4 + r) * SSTR + j * 16 + (lane & 15)] = acc[h * 4 + i4][j][r];
      asm volatile("s_waitcnt lgkmcnt(0)" ::: "memory");
#pragma unroll
      for (int it = 0; it < 16; ++it) {
        const int rr = it * 4 + (lane >> 4);
        const float4 v = *(const float4*)(stg + rr * SSTR + (lane & 15) * 4);
        epi.store4(m0 + wm * (BM / 2) + h * 64 + rr, n0 + wn * 64 + (lane & 15) * 4, v);
      }
      asm volatile("s_waitcnt lgkmcnt(0)" ::: "memory");
    }
  }
  asm volatile("s_waitcnt vmcnt(0)" ::: "memory");
  GEMM_RAWBAR();
}

template <class F>
__device__ __forceinline__ void for_gemm_tiles(int MT, int NT, F f) {
  const int xcd = blockIdx.x & 7, local = blockIdx.x >> 3, nloc = gridDim.x >> 3;
  const int SM = (MT + 7) >> 3, SN = (NT + 7) >> 3, nsup = SM * SN, per_xcd = (nsup + 7) >> 3;
  for (int idx = local; idx < per_xcd * 64; idx += nloc) {
    const int st = (idx >> 6) * 8 + xcd; if (st >= nsup) continue;
    const int within = idx & 63; const int mt = (st / SN) * 8 + (within >> 3), nt = (st % SN) * 8 + (within & 7);
    if (mt < MT && nt < NT) f(mt, nt);
  }
}

struct EpiProj { bf16_t* proj; float* dtraw;
  __device__ __forceinline__ void store4(int r, int c, float4 v) const {
    if (c < PJW) { uint2 o; o.x = pack2(v.x, v.y); o.y = pack2(v.z, v.w); *(uint2*)(proj + (size_t)r * PJW + c) = o; }
    else *(float4*)(dtraw + r * 64 + c - PJW) = v; } };
struct EpiBf16 { bf16_t* o; int ld;
  __device__ __forceinline__ void store4(int r, int c, float4 v) const { uint2 t; t.x = pack2(v.x, v.y); t.y = pack2(v.z, v.w); *(uint2*)(o + (size_t)r * ld + c) = t; } };
struct EpiOut { const float* x; float* o;
  __device__ __forceinline__ void store4(int r, int c, float4 v) const { size_t i = (size_t)r * D_ + c; float4 xv = *(const float4*)(x + i); *(float4*)(o + i) = make_float4(xv.x + v.x, xv.y + v.y, xv.z + v.z, xv.w + v.w); } };
struct EpiF32 { float* o; int ld;
  __device__ __forceinline__ void store4(int r, int c, float4 v) const { *(float4*)(o + (size_t)r * ld + c) = v; } };

__device__ __forceinline__ void late_transposes(const Params& p, int first, int stride, unsigned char* smem) {
  unsigned char* ws = p.ws;
  for (int t = first; t < 3072; t += stride) {
    if (t < 2048) transpose_tile(p.w_out, 4096, 4096, (bf16_t*)(ws + OFF_WOUT), t, (float*)smem);
    else transpose_tile(p.w_query, 4096, 2048, (bf16_t*)(ws + OFF_WQ), t - 2048, (float*)smem);
  }
}

__device__ __forceinline__ void fp8_convert_tiles(const Params& p, int first, int stride) {
  unsigned char* ws = p.ws; const float* eu = p.expert_u; const float* ev = p.expert_v;
  for (int t = first; t < 8192; t += stride) {
    const int tid2 = opaque_tid(); const int row = t * 4 + (tid2 >> 6); const int tb = row >> 14, r = row & 16383;
    fp8_row((tb ? ev : eu) + (size_t)r * 4096, ws + (tb ? OFF_EV8 : OFF_EU8) + (size_t)r * 4096, (float*)(ws + OFF_ESC) + row, tid2 & 63);
  }
}

__device__ __forceinline__ void phase0(const Params& p, unsigned char* smem) {
  unsigned char* ws = p.ws;
  const int n0 = 3904, n1 = n0 + 384, n2 = n1 + 256, n3 = n2 + 2048, n4 = n3 + 1024, n5 = n4 + 64, n6 = n5 + 2048;
  if (gridDim.x != 512) fp8_convert_tiles(p, blockIdx.x, gridDim.x);
  const int tid = opaque_tid(), lane = tid & 63, w = tid >> 6;
  for (int t = blockIdx.x; t < n6; t += gridDim.x) {
    if (t < n0) transpose_tile(p.w_in, 4096, 7808, (bf16_t*)(ws + OFF_WIN), t, (float*)smem);
    else if (t < n1) transpose_tile(p.w_uq, 1024, 3072, (bf16_t*)(ws + OFF_WUQ), t - n0, (float*)smem);
    else if (t < n2) transpose_tile(p.w_ukv, 512, 4096, (bf16_t*)(ws + OFF_WUKV), t - n1, (float*)smem);
    else if (t < n4) { if (gridDim.x != 512) late_transposes(p, t - n2, 1 << 30, smem); }

    else if (t < n5) {
      const int base = (t - n4) * 4096; bf16_t* sk = (bf16_t*)(ws + OFF_SK);
#pragma unroll
      for (int i = 0; i < 4; ++i) { int e = base + (tid + 256 * i) * 4; float4 v = *(const float4*)(p.sub_keys + e); uint2 o; o.x = pack2(v.x, v.y); o.y = pack2(v.z, v.w); *(uint2*)(sk + e) = o; }
    } else {
      const int row = (t - n5) * 4 + w;
      rms_row_f32<4096>(p.x + (size_t)row * D_, p.norm_mix, (bf16_t*)(ws + OFF_A) + (size_t)row * D_, lane);
    }
  }
}

__device__ __forceinline__ void phase1(const Params& p, unsigned char* smem) {
  unsigned char* ws = p.ws;
  EpiProj epi{(bf16_t*)(ws + OFF_B), (float*)(ws + OFF_DTRAW)};
  const bf16_t* A = (const bf16_t*)(ws + OFF_A); const bf16_t* B = (const bf16_t*)(ws + OFF_WIN);
  for_gemm_tiles(T_ / GBM, 61, [&](int mt, int nt) { gemm_tile<GBM, GNST>(A, 4096, B, 4096, 4096, mt * GBM, nt * 128, smem, epi); });
  if (gridDim.x == 512 && (blockIdx.x & 7) == 7 && ((blockIdx.x >> 3) & 7) >= 5) {
    const int local = blockIdx.x >> 3; const int bi = (local >> 3) * 3 + ((local & 7) - 5);
    for (int t = bi; t < FP8_EARLY; t += 24) fp8_convert_tiles(p, t, 1 << 30);
  }
}

__device__ __forceinline__ void phase2(const Params& p, unsigned char* smem) {
  unsigned char* ws = p.ws;
  const int tid = opaque_tid(), lane = tid & 63, w = tid >> 6;
  const bf16_t* proj = (const bf16_t*)(ws + OFF_B);
  for (int t = blockIdx.x; t < 16; t += gridDim.x) {
    const int gid = t * 256 + tid; const int h = gid & 31, c = (gid >> 5) & 15, b = (gid >> 9) & 3, dir = gid >> 11;
    const float alf = p.a_log_f[h], alb = p.a_log_b[h], dbf = p.dt_bias_f[h], dbb = p.dt_bias_b[h];
    const float a = -expf(dir ? alb : alf); const float bias = dir ? dbb : dbf;
    const float* dtraw = (const float*)(ws + OFF_DTRAW) + dir * 32 + h; float* DT = (float*)(ws + OFF_DT) + (size_t)dir * T_ * 32 + h; float* AC = (float*)(ws + OFF_ACUM) + (size_t)dir * T_ * 32 + h;
    const int tbase = b * S_ + c * 128; const int l0 = dir ? 127 : 0, ls = dir ? -1 : 1;
    float cum = 0.f;
#pragma unroll 1
    for (int i0 = 0; i0 < 128; i0 += 16) {
      float raw[16];
#pragma unroll
      for (int j = 0; j < 16; ++j) raw[j] = dtraw[(tbase + l0 + ls * (i0 + j)) * 64];
#pragma unroll
      for (int j = 0; j < 16; ++j) {
        const int tt = tbase + l0 + ls * (i0 + j);
        const float r = raw[j] + bias; const float dt = fmaxf(r, 0.f) + log1pf(expf(-fabsf(r)));
        cum += dt * a; DT[tt * 32] = dt; AC[tt * 32] = cum;
      }
    }
  }
  for (int t = blockIdx.x; t < T_ / 4; t += gridDim.x) {
    const int row = t * 4 + w;
    rms_row_bf16<1024>(proj + (size_t)row * PJW, p.q_a_norm, (bf16_t*)(ws + OFF_CQN) + (size_t)row * 1024, lane);
    rms_row_bf16<512>(proj + (size_t)row * PJW + 1024, p.kv_a_norm, (bf16_t*)(ws + OFF_CKVN) + (size_t)row * 512, lane);
  }
  bf16_t* xc = (bf16_t*)(ws + OFF_A);
  for (int t = blockIdx.x; t < T_ / 4 * 2; t += gridDim.x) {
    const int idx = t * 256 + tid; const int tg = idx >> 9, c = (idx & 511) * 8; const int t0 = tg * 4; const int s0 = t0 & (S_ - 1);
    u32x4 rows[8];
#pragma unroll
    for (int j = 0; j < 8; ++j) {
      const int ss = s0 + j - 2;
      rows[j] = (ss >= 0 && ss < S_) ? *(const u32x4*)(proj + (size_t)(t0 + j - 2) * PJW + 3648 + c) : (u32x4){0u, 0u, 0u, 0u};
    }
    float wgt[5][8], bia[8];
#pragma unroll
    for (int wv = 0; wv < 5; ++wv) {
      const float4 w0 = *(const float4*)(p.conv_w + wv * 4096 + c), w1 = *(const float4*)(p.conv_w + wv * 4096 + c + 4);
      wgt[wv][0] = w0.x; wgt[wv][1] = w0.y; wgt[wv][2] = w0.z; wgt[wv][3] = w0.w; wgt[wv][4] = w1.x; wgt[wv][5] = w1.y; wgt[wv][6] = w1.z; wgt[wv][7] = w1.w;
    }
    { const float4 b0 = *(const float4*)(p.conv_b + c), b1 = *(const float4*)(p.conv_b + c + 4); bia[0] = b0.x; bia[1] = b0.y; bia[2] = b0.z; bia[3] = b0.w; bia[4] = b1.x; bia[5] = b1.y; bia[6] = b1.z; bia[7] = b1.w; }
#pragma unroll
    for (int o = 0; o < 4; ++o) {
      float acc[8];
#pragma unroll
      for (int e = 0; e < 8; ++e) acc[e] = bia[e];
#pragma unroll
      for (int wv = 0; wv < 5; ++wv) {
        const u32x4 v = rows[o + wv];
#pragma unroll
        for (int q = 0; q < 4; ++q) { acc[2 * q] += bflo(v[q]) * wgt[wv][2 * q]; acc[2 * q + 1] += bfhi(v[q]) * wgt[wv][2 * q + 1]; }
      }
#pragma unroll
      for (int e = 0; e < 8; ++e) acc[e] = acc[e] / (1.f + __expf(-acc[e]));
      u32x4 ov; ov[0] = pack2(acc[0], acc[1]); ov[1] = pack2(acc[2], acc[3]); ov[2] = pack2(acc[4], acc[5]); ov[3] = pack2(acc[6], acc[7]);
      *(u32x4*)(xc + (size_t)(t0 + o) * 4096 + c) = ov;
    }
  }
}

__device__ __forceinline__ void ssd_states_tile(const Params& p, int tile, unsigned char* smem) {
  unsigned char* ws = p.ws;
  const int g = tile & 7, c = (tile >> 3) & 15, b = tile >> 7; const int t0 = b * S_ + c * 128;
  const int tid = opaque_tid(), lane = tid & 63, w = tid >> 6;
  bf16_t* sBT = (bf16_t*)smem;
  bf16_t* sXT = sBT + 128 * 136;
  const bf16_t* xc = (const bf16_t*)(ws + OFF_A);
#pragma unroll
  for (int i = 0; i < 4; ++i) {
    const int item = tid + 256 * i; const int lp = item >> 4, nc = item & 15;
    uint4 v0 = *(const uint4*)(xc + (size_t)(t0 + 2 * lp) * 4096 + 2048 + g * 128 + nc * 8);
    uint4 v1 = *(const uint4*)(xc + (size_t)(t0 + 2 * lp + 1) * 4096 + 2048 + g * 128 + nc * 8);
    unsigned a0[4] = {v0.x, v0.y, v0.z, v0.w}, a1[4] = {v1.x, v1.y, v1.z, v1.w};
#pragma unroll
    for (int j = 0; j < 4; ++j) {
      *(unsigned*)(sBT + (nc * 8 + 2 * j) * 136 + 2 * lp) = (a0[j] & 0xffffu) | (a1[j] << 16);
      *(unsigned*)(sBT + (nc * 8 + 2 * j + 1) * 136 + 2 * lp) = (a0[j] >> 16) | (a1[j] & 0xffff0000u);
    }
  }
#pragma unroll 1
  for (int dr = 0; dr < 8; ++dr) {
    const int dir = dr >> 2, r = dr & 3, hd = g * 4 + r;
    const float* DT = (const float*)(ws + OFF_DT) + (size_t)dir * T_ * 32; const float* AC = (const float*)(ws + OFF_ACUM) + (size_t)dir * T_ * 32;
    const float aend = AC[(t0 + (dir ? 0 : 127)) * 32 + hd];
#pragma unroll
    for (int i = 0; i < 2; ++i) {
      const int item = tid + 256 * i; const int lp = item >> 3, pc = item & 7;
      const int l0 = 2 * lp, l1 = 2 * lp + 1;
      const float w0 = DT[(t0 + l0) * 32 + hd] * expf(aend - AC[(t0 + l0) * 32 + hd]);
      const float w1 = DT[(t0 + l1) * 32 + hd] * expf(aend - AC[(t0 + l1) * 32 + hd]);
      uint4 v0 = *(const uint4*)(xc + (size_t)(t0 + l0) * 4096 + hd * 64 + pc * 8);
      uint4 v1 = *(const uint4*)(xc + (size_t)(t0 + l1) * 4096 + hd * 64 + pc * 8);
      unsigned a0[4] = {v0.x, v0.y, v0.z, v0.w}, a1[4] = {v1.x, v1.y, v1.z, v1.w};
#pragma unroll
      for (int j = 0; j < 4; ++j) {
        *(unsigned*)(sXT + (pc * 8 + 2 * j) * 136 + l0) = pack2(bflo(a0[j]) * w0, bflo(a1[j]) * w1);
        *(unsigned*)(sXT + (pc * 8 + 2 * j + 1) * 136 + l0) = pack2(bfhi(a0[j]) * w0, bfhi(a1[j]) * w1);
      }
    }
    __syncthreads();
    f32x4 acc[8];
#pragma unroll
    for (int j = 0; j < 8; ++j) acc[j] = (f32x4){0.f, 0.f, 0.f, 0.f};
#pragma unroll
    for (int ks = 0; ks < 4; ++ks) {
      bf16x8 af = *(const bf16x8*)(sXT + (16 * w + (lane & 15)) * 136 + ks * 32 + (lane >> 4) * 8);
#pragma unroll
      for (int j = 0; j < 8; ++j) {
        bf16x8 bfr = *(const bf16x8*)(sBT + (j * 16 + (lane & 15)) * 136 + ks * 32 + (lane >> 4) * 8);
        acc[j] = MFMA16(af, bfr, acc[j]);
      }
    }
    bf16_t* st = (bf16_t*)(ws + OFF_ST) + ((((size_t)(dir * 4 + b) * 16 + c) * 32 + hd) * 64) * 128;
    bf16_t* stg = sXT + 64 * 136 + w * (16 * 136);
#pragma unroll
    for (int j = 0; j < 8; ++j)
#pragma unroll
      for (int rr = 0; rr < 4; ++rr) stg[((lane >> 4) * 4 + rr) * 136 + j * 16 + (lane & 15)] = f2bf(acc[j][rr]);
    asm volatile("s_waitcnt lgkmcnt(0)" ::: "memory");
#pragma unroll
    for (int q = 0; q < 4; ++q) {
      const int cc = lane + 64 * q; const int row = cc >> 4, ch = cc & 15;
      *(u32x4*)(st + (16 * w + row) * 128 + ch * 8) = *(const u32x4*)(stg + row * 136 + ch * 8);
    }
    __syncthreads();
  }
}

__device__ __forceinline__ void phase3(const Params& p, unsigned char* smem) {
  unsigned char* ws = p.ws;
  { EpiBf16 epi{(bf16_t*)(ws + OFF_QRAW), 3072};
    const bf16_t* A = (const bf16_t*)(ws + OFF_CQN); const bf16_t* B = (const bf16_t*)(ws + OFF_WUQ);
    for_gemm_tiles(T_ / GBM, 24, [&](int mt, int nt) { gemm_tile<GBM, GNST>(A, 1024, B, 1024, 1024, mt * GBM, nt * 128, smem, epi); }); }
  { EpiBf16 epi{(bf16_t*)(ws + OFF_KVRAW), 4096};
    const bf16_t* A = (const bf16_t*)(ws + OFF_CKVN); const bf16_t* B = (const bf16_t*)(ws + OFF_WUKV);
    for_gemm_tiles(T_ / GBM, 32, [&](int mt, int nt) { gemm_tile<GBM, GNST>(A, 512, B, 512, 512, mt * GBM, nt * 128, smem, epi); }); }
  if (gridDim.x == 512 && (blockIdx.x & 7) >= 4) late_transposes(p, (blockIdx.x >> 3) * 4 + ((blockIdx.x & 7) - 4), 256, smem);
  for (int t = blockIdx.x; t < 512; t += gridDim.x) ssd_states_tile(p, t, smem);
}

__device__ __forceinline__ void phase4(const Params& p, unsigned char* smem) {
  unsigned char* ws = p.ws;
  const int tid = opaque_tid(), lane = tid & 63, w = tid >> 6;
  const bf16_t* proj = (const bf16_t*)(ws + OFF_B);
  const bf16_t* qraw = (const bf16_t*)(ws + OFF_QRAW); const bf16_t* kvraw = (const bf16_t*)(ws + OFF_KVRAW);
  const float qscale = 0.07216878364870322f * 1.4426950408889634f;
  const float* const qn_ = p.q_norm; const float* const kn_ = p.k_norm; const int* const pos_ = p.pos;
  const float gq0 = qn_[lane], gq1 = qn_[lane + 64], gq2 = qn_[lane + 128], gk0 = kn_[lane], gk1 = kn_[lane + 64], gk2 = kn_[lane + 128];
  const float invf = exp2f(-(float)(lane & 31) * (13.287712379549449f / 32.f));
  bf16_t* sm = (bf16_t*)smem;
  const unsigned prog = (gridDim.x == 512 && (blockIdx.x >> 3) >= 32) ? 0x021u : 0x210u;
#pragma unroll 1
  for (int step = 0; step < 3; ++step) {
    const int work = (prog >> (4 * step)) & 15;
    if (work == 0) {
  for (int t = blockIdx.x; t < 1024; t += gridDim.x) {
    const int gid = t * 256 + tid; const int nch = gid & 15, pp = (gid >> 4) & 63, h = (gid >> 10) & 31, b = (gid >> 15) & 3, dir = gid >> 17;
    const float* AC = (const float*)(ws + OFF_ACUM) + (size_t)dir * T_ * 32;
    bf16_t* base = (bf16_t*)(ws + OFF_ST) + ((((size_t)(dir * 4 + b) * 16) * 32 + h) * 64 + pp) * 128 + nch * 8;
    u32x4 sv[16]; float dec[16];
#pragma unroll
    for (int i = 0; i < 16; ++i) {
      const int c = dir ? 15 - i : i;
      sv[i] = *(const u32x4*)(base + (size_t)c * (32 * 64 * 128));
      dec[i] = AC[(b * S_ + c * 128 + (dir ? 0 : 127)) * 32 + h];
    }
    float hs[8];
#pragma unroll
    for (int j = 0; j < 8; ++j) hs[j] = 0.f;
#pragma unroll
    for (int i = 0; i < 16; ++i) {
      const int c = dir ? 15 - i : i;
      u32x4 o; o[0] = pack2(hs[0], hs[1]); o[1] = pack2(hs[2], hs[3]); o[2] = pack2(hs[4], hs[5]); o[3] = pack2(hs[6], hs[7]);
      *(u32x4*)(base + (size_t)c * (32 * 64 * 128)) = o;
      const float d = expf(dec[i]);
#pragma unroll
      for (int q = 0; q < 4; ++q) { hs[2 * q] = hs[2 * q] * d + bflo(sv[i][q]); hs[2 * q + 1] = hs[2 * q + 1] * d + bfhi(sv[i][q]); }
    }
  }
    } else if (work == 1) {
  for (int tt = blockIdx.x * 4 + w; tt < T_; tt += gridDim.x * 4) {
    const float posf = (float)pos_[tt];
    float sn, cs; sincosf(posf * invf, &sn, &cs);
    const int b = tt >> 11, sq = tt & (S_ - 1);
    const float kr = bf2f(proj[(size_t)tt * PJW + 1536 + lane]);
    float x0[4], x1[4], x2[4], n0[4], n1[4], n2[4];
#define QK_LOAD(HQ, X0, X1, X2) do { const int wh_ = (HQ) >> 2, hh_ = ((HQ) & 3) * 4;                                       \
      _Pragma("unroll") for (int j = 0; j < 4; ++j) {                                                                       \
        const bf16_t* sp = wh_ ? (kvraw + (size_t)tt * 4096 + (hh_ + j) * 256) : (qraw + (size_t)tt * 3072 + (hh_ + j) * 192); \
        X0[j] = bf2f(sp[lane]); X1[j] = bf2f(sp[lane + 64]); X2[j] = wh_ ? kr : bf2f(sp[lane + 128]); } } while (0)
#define QK_PROC(HQ, X0, X1, X2) do { const int which = (HQ) >> 2, h0 = ((HQ) & 3) * 4;                                      \
      const float g0 = which ? gk0 : gq0, g1 = which ? gk1 : gq1, g2 = which ? gk2 : gq2;                                  \
      const float scl = which ? 1.f : qscale;                                                                               \
      bf16_t* dbase = (bf16_t*)(ws + (which == 0 ? OFF_Q : OFF_K)) + ((size_t)(b * 16 + h0) * S_ + sq) * 192;              \
      _Pragma("unroll") for (int j = 0; j < 4; ++j) {                                                                       \
        const float ss = wave_sum_fast(X0[j] * X0[j] + X1[j] * X1[j] + X2[j] * X2[j]);                                      \
        const float r = rsqrtf(ss * (1.f / 192.f) + 1e-6f);                                                                 \
        const float y0 = X0[j] * r * g0, y1 = X1[j] * r * g1, y2 = X2[j] * r * g2;                                          \
        const float other = __shfl_xor(y2, 32);                                                                             \
        const float yr = (lane < 32) ? (y2 * cs - other * sn) : (other * sn + y2 * cs);                                     \
        bf16_t* dst = dbase + (size_t)j * S_ * 192;                                                                         \
        dst[lane] = f2bf(y0 * scl); dst[lane + 64] = f2bf(y1 * scl); dst[lane + 128] = f2bf(yr * scl); } } while (0)
    QK_LOAD(0, x0, x1, x2);
#pragma unroll 1
    for (int hq = 0; hq < 8; hq += 2) {
      QK_LOAD(hq + 1, n0, n1, n2);
      QK_PROC(hq, x0, x1, x2);
      if (hq + 2 < 8) QK_LOAD(hq + 2, x0, x1, x2);
      QK_PROC(hq + 1, n0, n1, n2);
    }
#undef QK_LOAD
#undef QK_PROC
  }
    } else {
  for (int t = blockIdx.x; t < 2048; t += gridDim.x) {
    const int sb = t & 31, head = (t >> 5) & 15, b = t >> 9; const int tbase = b * S_ + sb * 64;
    __syncthreads();
#pragma unroll
    for (int i = 0; i < 4; ++i) {
      const int cidx = tid + 256 * i; const int srow = cidx >> 4, dc = cidx & 15;
      uint4 v = *(const uint4*)(kvraw + (size_t)(tbase + srow) * 4096 + head * 256 + 128 + dc * 8);
      unsigned a[4] = {v.x, v.y, v.z, v.w};
#pragma unroll
      for (int j = 0; j < 4; ++j) { sm[(dc * 8 + 2 * j) * 72 + srow] = (bf16_t)(a[j] & 0xffffu); sm[(dc * 8 + 2 * j + 1) * 72 + srow] = (bf16_t)(a[j] >> 16); }
    }
    __syncthreads();
    bf16_t* vt = (bf16_t*)(ws + OFF_VT) + (size_t)(b * 16 + head) * 128 * S_ + sb * 64;
#pragma unroll
    for (int i = 0; i < 4; ++i) {
      const int cidx = tid + 256 * i; const int d = cidx >> 3, sc8 = cidx & 7;
      *(uint4*)(vt + (size_t)d * S_ + sc8 * 8) = *(const uint4*)(sm + d * 72 + sc8 * 8);
    }
  }
    }
  }
}

__device__ __forceinline__ void attn_tile(const Params& p, int tile, unsigned char* smem) {
  unsigned char* ws = p.ws;
  const int qb = tile & 15, head = (tile >> 4) & 15, b = tile >> 8;
  const int tid = opaque_tid(), lane = tid & 63, w = tid >> 6, lr = lane & 31, lh = lane >> 5;
  bf16_t* sK = (bf16_t*)smem;
  bf16_t* sV = sK + 64 * 200;
  const bf16_t* Qp = (const bf16_t*)(ws + OFF_Q) + ((size_t)(b * 16 + head) * S_ + qb * 128 + w * 32) * 192;
  const bf16_t* Kp = (const bf16_t*)(ws + OFF_K) + (size_t)(b * 16 + head) * S_ * 192;
  const bf16_t* Vp = (const bf16_t*)(ws + OFF_VT) + (size_t)(b * 16 + head) * 128 * S_;
  bf16x8 qf[12];
#pragma unroll
  for (int ks = 0; ks < 12; ++ks) qf[ks] = *(const bf16x8*)(Qp + lr * 192 + ks * 16 + lh * 8);
  f32x16 o[4];
#pragma unroll
  for (int d = 0; d < 4; ++d)
#pragma unroll
    for (int r = 0; r < 16; ++r) o[d][r] = 0.f;
  float m = -INFINITY, lsum = 0.f;
  u32x4 rk[6], rv[4];
  int koff[6];
#pragma unroll
  for (int i = 0; i < 6; ++i) { const int cidx = tid + 256 * i; const int row = cidx / 24; koff[i] = row * 200 + (cidx - row * 24) * 8; }
  const int vrow_ = tid >> 3, vkc = (tid & 7) * 8;
  const int vpos = (vkc & ~15) + ((vkc & 8) ? 4 : 0);
#pragma unroll
  for (int i = 0; i < 6; ++i) rk[i] = *(const u32x4*)(Kp + (size_t)(tid + 256 * i) * 8);
#pragma unroll
  for (int i = 0; i < 4; ++i) rv[i] = *(const u32x4*)(Vp + (size_t)(vrow_ + 32 * i) * S_ + vkc);
#pragma unroll 1
  for (int kt = 0; kt < 32; ++kt) {
    __syncthreads();
#pragma unroll
    for (int i = 0; i < 6; ++i) *(u32x4*)(sK + koff[i]) = rk[i];
#pragma unroll
    for (int i = 0; i < 4; ++i) { bf16_t* d = sV + (vrow_ + 32 * i) * 72 + vpos; *(u32x2*)d = (u32x2){rv[i][0], rv[i][1]}; *(u32x2*)(d + 8) = (u32x2){rv[i][2], rv[i][3]}; }
    __syncthreads();
    if (kt + 1 < 32) {
      const int key0 = (kt + 1) * 64;
#pragma unroll
      for (int i = 0; i < 6; ++i) rk[i] = *(const u32x4*)(Kp + (size_t)key0 * 192 + (size_t)(tid + 256 * i) * 8);
#pragma unroll
      for (int i = 0; i < 4; ++i) rv[i] = *(const u32x4*)(Vp + (size_t)(vrow_ + 32 * i) * S_ + key0 + vkc);
    }
    f32x16 s0, s1;
#pragma unroll
    for (int r = 0; r < 16; ++r) { s0[r] = 0.f; s1[r] = 0.f; }
    const bf16_t* kb0 = sK + lr * 200 + lh * 8; const bf16_t* kb1 = kb0 + 32 * 200;
#pragma unroll
    for (int ks = 0; ks < 12; ++ks) { const bf16x8 kf = *(const bf16x8*)(kb0 + ks * 16); s0 = MFMA32(kf, qf[ks], s0); }
    {
      float mx = fmaxf(fmaxf(s0[0], s0[1]), fmaxf(s0[2], s0[3]));
#pragma unroll
      for (int r = 4; r < 16; ++r) mx = fmaxf(mx, s0[r]);
      mx = fmaxf(mx, __shfl_xor(mx, 32));
      const float mn = fmaxf(m, mx);
      if (__builtin_amdgcn_ballot_w64(mx > m + 8.f) != 0) {
        const float alpha = __builtin_amdgcn_exp2f(m - mn); lsum *= alpha;
#pragma unroll
        for (int d = 0; d < 4; ++d)
#pragma unroll
          for (int r = 0; r < 16; ++r) o[d][r] *= alpha;
        m = mn;
      }
    }
#pragma unroll
    for (int ks = 0; ks < 12; ++ks) { const bf16x8 kf = *(const bf16x8*)(kb1 + ks * 16); s1 = MFMA32(kf, qf[ks], s1); }
    float psA = 0.f;
#pragma unroll
    for (int r = 0; r < 16; ++r) { const float e = __builtin_amdgcn_exp2f(s0[r] - m); s0[r] = e; psA += e; }
    {
      float mx = fmaxf(fmaxf(s1[0], s1[1]), fmaxf(s1[2], s1[3]));
#pragma unroll
      for (int r = 4; r < 16; ++r) mx = fmaxf(mx, s1[r]);
      mx = fmaxf(mx, __shfl_xor(mx, 32));
      const float mn = fmaxf(m, mx);
      if (__builtin_amdgcn_ballot_w64(mx > m + 8.f) != 0) {
        const float alpha = __builtin_amdgcn_exp2f(m - mn); lsum *= alpha; psA *= alpha;
#pragma unroll
        for (int r = 0; r < 16; ++r) s0[r] *= alpha;
#pragma unroll
        for (int d = 0; d < 4; ++d)
#pragma unroll
          for (int r = 0; r < 16; ++r) o[d][r] *= alpha;
        m = mn;
      }
    }
    lsum += psA;
    const bf16_t* vb = sV + lr * 72 + lh * 8;
#pragma unroll
    for (int sh = 0; sh < 2; ++sh) {
      const bf16x8 pf = pack8(s0[8 * sh + 0], s0[8 * sh + 1], s0[8 * sh + 2], s0[8 * sh + 3], s0[8 * sh + 4], s0[8 * sh + 5], s0[8 * sh + 6], s0[8 * sh + 7]);
#pragma unroll
      for (int d = 0; d < 4; ++d) { const bf16x8 af = *(const bf16x8*)(vb + d * 32 * 72 + sh * 16); o[d] = MFMA32(af, pf, o[d]); }
    }
    float psB = 0.f;
#pragma unroll
    for (int r = 0; r < 16; ++r) { const float e = __builtin_amdgcn_exp2f(s1[r] - m); s1[r] = e; psB += e; }
    lsum += psB;
#pragma unroll
    for (int sh = 0; sh < 2; ++sh) {
      const bf16x8 pf = pack8(s1[8 * sh + 0], s1[8 * sh + 1], s1[8 * sh + 2], s1[8 * sh + 3], s1[8 * sh + 4], s1[8 * sh + 5], s1[8 * sh + 6], s1[8 * sh + 7]);
#pragma unroll
      for (int d = 0; d < 4; ++d) { const bf16x8 af = *(const bf16x8*)(vb + d * 32 * 72 + 32 + sh * 16); o[d] = MFMA32(af, pf, o[d]); }
    }
  }
  const float lt = lsum + __shfl_xor(lsum, 32); const float inv = 1.f / lt;
  float ss = 0.f;
#pragma unroll
  for (int d = 0; d < 4; ++d)
#pragma unroll
    for (int r = 0; r < 16; ++r) { o[d][r] *= inv; ss += o[d][r] * o[d][r]; }
  ss += __shfl_xor(ss, 32);
  const float rstd = rsqrtf(ss * (1.f / 128.f) + 1e-6f);
  const int tt = b * S_ + qb * 128 + w * 32 + lr;
  bf16_t* mix = (bf16_t*)(ws + OFF_MIX) + (size_t)tt * 4096 + head * 128;
  const float* gn = p.attn_out_norm + head * 128;
#pragma unroll
  for (int d = 0; d < 4; ++d)
#pragma unroll
    for (int rg = 0; rg < 4; ++rg) {
      const int dd = d * 32 + 8 * rg + 4 * lh;
      float4 g = *(const float4*)(gn + dd); uint2 ov;
      ov.x = pack2(o[d][4 * rg + 0] * rstd * g.x, o[d][4 * rg + 1] * rstd * g.y); ov.y = pack2(o[d][4 * rg + 2] * rstd * g.z, o[d][4 * rg + 3] * rstd * g.w);
      *(uint2*)(mix + dd) = ov;
    }
}

__device__ __forceinline__ void ssd_out_tile(const Params& p, int tile, unsigned char* smem) {
  unsigned char* ws = p.ws;
  const int g = tile & 7, c = (tile >> 3) & 15, b = tile >> 7; const int t0 = b * S_ + c * 128;
  const int tid = opaque_tid(), lane = tid & 63, w = tid >> 6, lr = lane & 31, lh = lane >> 5;
  bf16_t* sC = (bf16_t*)smem;
  bf16_t* sB = sC + 128 * 136;
  bf16_t* sXT = sB;
  float* sAc = (float*)(sB + 64 * 132);
  float* sDt = sAc + 128;
  bf16_t* sH = (bf16_t*)(sDt + 128);
  const bf16_t* xc = (const bf16_t*)(ws + OFF_A);
  const bf16_t* proj = (const bf16_t*)(ws + OFF_B);
  __syncthreads();
#pragma unroll
  for (int i = 0; i < 8; ++i) {
    const int cidx = tid + 256 * i; const int row = cidx >> 4, nc = cidx & 15;
    *(uint4*)(sB + row * 136 + nc * 8) = *(const uint4*)(xc + (size_t)(t0 + row) * 4096 + 2048 + g * 128 + nc * 8);
    *(uint4*)(sC + row * 136 + nc * 8) = *(const uint4*)(xc + (size_t)(t0 + row) * 4096 + 3072 + g * 128 + nc * 8);
  }
  __syncthreads();
  const int l0 = 32 * w, lidx = l0 + lr;
  bf16x8 cfr[8];
#pragma unroll
  for (int ks = 0; ks < 8; ++ks) cfr[ks] = *(const bf16x8*)(sC + lidx * 136 + ks * 16 + lh * 8);
  f32x16 G[4];
#pragma unroll
  for (int st = 0; st < 4; ++st) {
#pragma unroll
    for (int r = 0; r < 16; ++r) G[st][r] = 0.f;
#pragma unroll
    for (int ks = 0; ks < 8; ++ks) {
      bf16x8 af = *(const bf16x8*)(sB + (st * 32 + lr) * 136 + ks * 16 + lh * 8);
      G[st] = MFMA32(af, cfr[ks], G[st]);
    }
  }
  const int tt = t0 + lidx;
  bf16_t* mixrow = (bf16_t*)(ws + OFF_MIX) + (size_t)tt * 4096 + 2048 + g * 256;
  float ssq = 0.f;
#pragma unroll 1
  for (int r = 0; r < 4; ++r) {
    const int hd = g * 4 + r;
    __syncthreads();
#pragma unroll
    for (int i = 0; i < 2; ++i) {
      const int item = tid + 256 * i; const int sp = item >> 3, pc = item & 7;
      uint4 v0 = *(const uint4*)(xc + (size_t)(t0 + 2 * sp) * 4096 + hd * 64 + pc * 8);
      uint4 v1 = *(const uint4*)(xc + (size_t)(t0 + 2 * sp + 1) * 4096 + hd * 64 + pc * 8);
      unsigned a0[4] = {v0.x, v0.y, v0.z, v0.w}, a1[4] = {v1.x, v1.y, v1.z, v1.w};
#pragma unroll
      for (int j = 0; j < 4; ++j) {
        *(unsigned*)(sXT + (pc * 8 + 2 * j) * 132 + 2 * sp) = (a0[j] & 0xffffu) | (a1[j] << 16);
        *(unsigned*)(sXT + (pc * 8 + 2 * j + 1) * 132 + 2 * sp) = (a0[j] >> 16) | (a1[j] & 0xffff0000u);
      }
    }
    f32x16 y[2];
#pragma unroll
    for (int pt = 0; pt < 2; ++pt)
#pragma unroll
      for (int rr = 0; rr < 16; ++rr) y[pt][rr] = 0.f;
#pragma unroll 1
    for (int dir = 0; dir < 2; ++dir) {
      const float* DT = (const float*)(ws + OFF_DT) + (size_t)dir * T_ * 32; const float* AC = (const float*)(ws + OFF_ACUM) + (size_t)dir * T_ * 32;
      const bf16_t* hin = (const bf16_t*)(ws + OFF_ST) + ((((size_t)(dir * 4 + b) * 16 + c) * 32 + hd) * 64) * 128;
      u32x4 hreg[4];
#pragma unroll
      for (int q = 0; q < 4; ++q) { const int cc = tid + 256 * q; hreg[q] = *(const u32x4*)(hin + (cc >> 4) * 128 + (cc & 15) * 8); }
      __syncthreads();
      if (tid < 128) { sAc[tid] = AC[(t0 + tid) * 32 + hd]; sDt[tid] = DT[(t0 + tid) * 32 + hd]; }
#pragma unroll
      for (int q = 0; q < 4; ++q) { const int cc = tid + 256 * q; *(u32x4*)(sH + (cc >> 4) * 136 + (cc & 15) * 8) = hreg[q]; }
      __syncthreads();
      const float acl = sAc[lidx];
      const int sgn = 1 - 2 * dir;
#pragma unroll
      for (int st = 0; st < 4; ++st)
#pragma unroll
        for (int sh = 0; sh < 2; ++sh) {
          const int sb0 = st * 32 + sh * 16 + lh * 4;
          float4 a0 = *(const float4*)(sAc + sb0), a1 = *(const float4*)(sAc + sb0 + 8);
          float4 d0 = *(const float4*)(sDt + sb0), d1 = *(const float4*)(sDt + sb0 + 8);
          float av[8] = {a0.x, a0.y, a0.z, a0.w, a1.x, a1.y, a1.z, a1.w};
          float dv[8] = {d0.x, d0.y, d0.z, d0.w, d1.x, d1.y, d1.z, d1.w};
          float mv[8];
#pragma unroll
          for (int j = 0; j < 8; ++j) {
            const int sidx = sb0 + (j & 3) + 8 * (j >> 2);
            const float ex = ((lidx - sidx) * sgn >= 0) ? (acl - av[j]) : -INFINITY;
            mv[j] = G[st][8 * sh + j] * (__expf(ex) * dv[j]);
          }
          bf16x8 mf = pack8(mv[0], mv[1], mv[2], mv[3], mv[4], mv[5], mv[6], mv[7]);
#pragma unroll
          for (int pt = 0; pt < 2; ++pt) {
            const bf16_t* xrow = sXT + (pt * 32 + lr) * 132 + sb0;
            bf16x8 af = mk8(*(const uint2*)xrow, *(const uint2*)(xrow + 8));
            y[pt] = MFMA32(af, mf, y[pt]);
          }
        }
      f32x16 yo[2];
#pragma unroll
      for (int pt = 0; pt < 2; ++pt)
#pragma unroll
        for (int rr = 0; rr < 16; ++rr) yo[pt][rr] = 0.f;
#pragma unroll
      for (int ks = 0; ks < 8; ++ks)
#pragma unroll
        for (int pt = 0; pt < 2; ++pt) {
          bf16x8 hf = *(const bf16x8*)(sH + (pt * 32 + lr) * 136 + ks * 16 + lh * 8);
          yo[pt] = MFMA32(hf, cfr[ks], yo[pt]);
        }
      const float el = expf(acl);
#pragma unroll
      for (int pt = 0; pt < 2; ++pt)
#pragma unroll
        for (int rr = 0; rr < 16; ++rr) y[pt][rr] += el * yo[pt][rr];
    }
    const float dsk = p.d_skip[hd];
#pragma unroll
    for (int pt = 0; pt < 2; ++pt)
#pragma unroll
      for (int rg = 0; rg < 4; ++rg) {
        const int pp = pt * 32 + 8 * rg + 4 * lh; const int ch = hd * 64 + pp;
        uint2 xv = *(const uint2*)(xc + (size_t)tt * 4096 + ch);
        uint2 zv = *(const uint2*)(proj + (size_t)tt * PJW + 1600 + ch);
        float xs4[4] = {bflo(xv.x), bfhi(xv.x), bflo(xv.y), bfhi(xv.y)};
        float zs4[4] = {bflo(zv.x), bfhi(zv.x), bflo(zv.y), bfhi(zv.y)};
        float yv[4];
#pragma unroll
        for (int j = 0; j < 4; ++j) { float v = y[pt][4 * rg + j] + dsk * xs4[j]; v *= zs4[j] / (1.f + __expf(-zs4[j])); yv[j] = v; ssq += v * v; }
        uint2 ov; ov.x = pack2(yv[0], yv[1]); ov.y = pack2(yv[2], yv[3]);
        *(uint2*)(mixrow + r * 64 + pp) = ov;
      }
  }
  ssq += __shfl_xor(ssq, 32);
  const float rstd = rsqrtf(ssq * (1.f / 256.f) + 1e-6f);
  __threadfence_block();
#pragma unroll
  for (int r = 0; r < 4; ++r)
#pragma unroll
    for (int pt = 0; pt < 2; ++pt)
#pragma unroll
      for (int rg = 0; rg < 4; ++rg) {
        const int pp = pt * 32 + 8 * rg + 4 * lh;
        uint2 v = *(uint2*)(mixrow + r * 64 + pp);
        float4 gn = *(const float4*)(p.ssm_out_norm + g * 256 + r * 64 + pp);
        uint2 ov; ov.x = pack2(bflo(v.x) * rstd * gn.x, bfhi(v.x) * rstd * gn.y); ov.y = pack2(bflo(v.y) * rstd * gn.z, bfhi(v.y) * rstd * gn.w);
        *(uint2*)(mixrow + r * 64 + pp) = ov;
      }
}

__device__ __forceinline__ void phase5(const Params& p, unsigned char* smem) {
  const int xcd = blockIdx.x & 7, local = blockIdx.x >> 3, nloc = gridDim.x >> 3;
  if (gridDim.x == 512) {
    const int conv_step = (local >= 32) ? 1 : 0;
#pragma unroll 1
    for (int step = 0; step < 3; ++step) {
      if (step == conv_step) fp8_convert_tiles(p, FP8_EARLY + blockIdx.x, 512);
      else {
        const int idx = local + 64 * ((step > conv_step) ? step - 1 : step);
        attn_tile(p, ((idx >> 6) * 8 + xcd) * 64 + (idx & 63), smem);
      }
    }
  } else {
    for (int idx = local; idx < 128; idx += nloc) attn_tile(p, ((idx >> 6) * 8 + xcd) * 64 + (idx & 63), smem);
  }
  for (int t = blockIdx.x; t < 512; t += gridDim.x) ssd_out_tile(p, t, smem);
}

__device__ __forceinline__ void phase6(const Params& p, unsigned char* smem) {
  unsigned char* ws = p.ws;
  EpiOut epi{p.x, p.out};
  const bf16_t* A = (const bf16_t*)(ws + OFF_MIX); const bf16_t* B = (const bf16_t*)(ws + OFF_WOUT);
  for_gemm_tiles(T_ / GBM, 32, [&](int mt, int nt) { gemm_tile<GBM, GNST>(A, 4096, B, 4096, 4096, mt * GBM, nt * 128, smem, epi); });
}

__device__ __forceinline__ void phase7(const Params& p, unsigned char* smem) {
  unsigned char* ws = p.ws; const int tid = opaque_tid(); const int lane = tid & 63, w = tid >> 6;
  for (int t = blockIdx.x; t < T_ / 4; t += gridDim.x) {
    const int row = t * 4 + w;
    rms_row_f32<4096>(p.out + (size_t)row * D_, p.norm_ffn, (bf16_t*)(ws + OFF_A) + (size_t)row * D_, lane);
  }
}

__device__ __forceinline__ void phase8(const Params& p, unsigned char* smem) {
  unsigned char* ws = p.ws;
  EpiBf16 epi{(bf16_t*)(ws + OFF_QP), 2048};
  const bf16_t* A = (const bf16_t*)(ws + OFF_A); const bf16_t* B = (const bf16_t*)(ws + OFF_WQ);
  for_gemm_tiles(T_ / GBM, 16, [&](int mt, int nt) { gemm_tile<GBM, GNST>(A, 4096, B, 4096, 4096, mt * GBM, nt * 128, smem, epi); });
}

__device__ __forceinline__ void phase9(const Params& p, unsigned char* smem) {
  unsigned char* ws = p.ws;
  EpiF32 epi{(float*)(ws + OFF_SC), 2048};
  const bf16_t* A = (const bf16_t*)(ws + OFF_QP); const bf16_t* B = (const bf16_t*)(ws + OFF_SK);
  for (int t = blockIdx.x; t < 1024; t += gridDim.x) {
    const int blk = t & 15, mt = t >> 4;
    gemm_tile<128, 4>(A + blk * 128, 2048, B, 128, 128, mt * 128, blk * 128, smem, epi);
  }
}

#define WAVE_LDS_FENCE() asm volatile("s_waitcnt lgkmcnt(0)" ::: "memory")
#define WAVE_LDS_FENCE() asm volatile("s_waitcnt lgkmcnt(0)" ::: "memory")
__device__ __forceinline__ void topk16_rank(const float a, const float b, int lane, unsigned* skey, float* tv, int* ti) {
  const unsigned ka = (fkey(a) & ~127u) | (unsigned)(127 - lane), kb = (fkey(b) & ~127u) | (unsigned)(63 - lane);
  unsigned T = 0u;
#pragma unroll
  for (int bit = 31; bit >= 0; --bit) {
    const unsigned c = T | (1u << bit);
    const int cnt = __builtin_popcountll(__builtin_amdgcn_ballot_w64(ka >= c)) + __builtin_popcountll(__builtin_amdgcn_ballot_w64(kb >= c));
    T = (cnt >= 16) ? c : T;
  }
  const bool sa = ka >= T, sb = kb >= T;
  const unsigned long long ma = __builtin_amdgcn_ballot_w64(sa), mb = __builtin_amdgcn_ballot_w64(sb);
  const int pa = (int)__builtin_amdgcn_mbcnt_hi((unsigned)(ma >> 32), __builtin_amdgcn_mbcnt_lo((unsigned)ma, 0u));
  const int pb = __builtin_popcountll(ma) + (int)__builtin_amdgcn_mbcnt_hi((unsigned)(mb >> 32), __builtin_amdgcn_mbcnt_lo((unsigned)mb, 0u));
  float* sval = (float*)(skey + 16); int* sidx = (int*)(skey + 32);
  if (sa) { skey[pa & 15] = ka; sval[pa & 15] = a; sidx[pa & 15] = lane; }
  if (sb) { skey[pb & 15] = kb; sval[pb & 15] = b; sidx[pb & 15] = lane + 64; }
  WAVE_LDS_FENCE();
  {
    const unsigned mk = skey[lane & 15]; const float mv = sval[lane & 15]; const int mi = sidx[lane & 15];
    int rank = 0;
#pragma unroll
    for (int j4 = 0; j4 < 4; ++j4) {
      const u32x4 x = *(const u32x4*)(skey + 4 * j4);
#pragma unroll
      for (int e = 0; e < 4; ++e) rank += (x[e] > mk) ? 1 : 0;
    }
    if (lane < 16) { tv[rank] = mv; ti[rank] = mi; }
  }
  WAVE_LDS_FENCE();
}

__device__ __forceinline__ void peer_fma(const u32x4 (&u)[4], const unsigned (&hvp)[32], float& dot) {
#pragma unroll
  for (int i = 0; i < 4; ++i)
#pragma unroll
    for (int q = 0; q < 4; ++q) {
      const int wd = (int)u[i][q];
      const f32x2_t lo = __builtin_amdgcn_cvt_pk_f32_fp8(wd, false), hi = __builtin_amdgcn_cvt_pk_f32_fp8(wd, true);
      const unsigned h0 = hvp[8 * i + 2 * q], h1 = hvp[8 * i + 2 * q + 1];
      dot += lo[0] * bflo(h0) + lo[1] * bfhi(h0) + hi[0] * bflo(h1) + hi[1] * bfhi(h1);
    }
}
__device__ __forceinline__ void peer_axpy(const u32x4 (&v)[4], float coef, float (&acc)[64]) {
#pragma unroll
  for (int i = 0; i < 4; ++i)
#pragma unroll
    for (int q = 0; q < 4; ++q) {
      const int wd = (int)v[i][q];
      const f32x2_t lo = __builtin_amdgcn_cvt_pk_f32_fp8(wd, false), hi = __builtin_amdgcn_cvt_pk_f32_fp8(wd, true);
      acc[16 * i + 4 * q] += coef * lo[0]; acc[16 * i + 4 * q + 1] += coef * lo[1]; acc[16 * i + 4 * q + 2] += coef * hi[0]; acc[16 * i + 4 * q + 3] += coef * hi[1];
    }
}

__device__ __forceinline__ void phase10(const Params& p, unsigned char* smem) {
  unsigned char* ws = p.ws; const int tid = opaque_tid(), lane = tid & 63, w = tid >> 6;
  unsigned char* wb = smem + w * 4096;
  unsigned* skey = (unsigned*)wb;
  float* tv = (float*)(wb + 512);
  int* ti = (int*)(wb + 640);
  float* cs = (float*)(wb + 768);
  int* cf = (int*)(wb + 1024);
  float* ts = (float*)(wb + 1280);
  int* te = (int*)(wb + 1344);
  int* s_idx = (int*)(wb + 1536);
  float* s_gate = (float*)(wb + 2048);
  const float* SC = (const float*)(ws + OFF_SC); const bf16_t* hn = (const bf16_t*)(ws + OFF_A);
  const unsigned char* EU = ws + OFF_EU8; const unsigned char* EV = ws + OFF_EV8;
  const float* SU = (const float*)(ws + OFF_ESC); const float* SV = SU + 16384;
  int ci = 0, cj = 0;
  { int cnt = 0;
#pragma unroll
    for (int i = 0; i < 16; ++i) { const int n = 16 / (i + 1); if (lane >= cnt && lane < cnt + n) { ci = i; cj = lane - cnt; } cnt += n; } }
  for (int t = blockIdx.x; t < T_ / 4; t += gridDim.x) {
    const int tt = t * 4 + w;
    WAVE_LDS_FENCE();
    float sca[16], scb[16];
#pragma unroll
    for (int l = 0; l < 16; ++l) { sca[l] = SC[(size_t)tt * 2048 + l * 128 + lane]; scb[l] = SC[(size_t)tt * 2048 + l * 128 + 64 + lane]; }
#pragma unroll
    for (int h = 0; h < 8; ++h) {
      topk16_rank(sca[2 * h], scb[2 * h], lane, skey, tv, ti);
      topk16_rank(sca[2 * h + 1], scb[2 * h + 1], lane, skey, tv + 16, ti + 16);
      const float c = (lane < 50) ? tv[ci] + tv[16 + cj] : -INFINITY; const int fl = ci * 16 + cj;
      cs[lane] = c; cf[lane] = fl;
      WAVE_LDS_FENCE();
      int rank = 0;
#pragma unroll
      for (int l4 = 0; l4 < 13; ++l4) {
        const float4 c4 = *(const float4*)(cs + 4 * l4); const int4 f4 = *(const int4*)(cf + 4 * l4);
        rank += (c4.x > c || (c4.x == c && f4.x < fl)) ? 1 : 0; rank += (c4.y > c || (c4.y == c && f4.y < fl)) ? 1 : 0;
        rank += (c4.z > c || (c4.z == c && f4.z < fl)) ? 1 : 0; rank += (c4.w > c || (c4.w == c && f4.w < fl)) ? 1 : 0;
      }
      if (lane < 50 && rank < 16) { ts[rank] = c; te[rank] = ti[ci] * 128 + ti[16 + cj]; }
      WAVE_LDS_FENCE();
      const float tsv = ts[lane & 15]; const float ex = expf(tsv - ts[0]);
      float sum = ex; sum += __shfl_xor(sum, 8); sum += __shfl_xor(sum, 4); sum += __shfl_xor(sum, 2); sum += __shfl_xor(sum, 1);
      if (lane < 16) { s_idx[h * 16 + lane] = te[lane]; s_gate[h * 16 + lane] = ex / sum; }
    }
    WAVE_LDS_FENCE();
    unsigned hv[32]; float acc[64];
#pragma unroll
    for (int i = 0; i < 4; ++i) {
      const u32x4 h0 = *(const u32x4*)(hn + (size_t)tt * 4096 + 16 * (lane + 64 * i)), h1 = *(const u32x4*)(hn + (size_t)tt * 4096 + 16 * (lane + 64 * i) + 8);
#pragma unroll
      for (int q = 0; q < 4; ++q) { hv[8 * i + q] = h0[q]; hv[8 * i + 4 + q] = h1[q]; }
    }
#pragma unroll
    for (int i = 0; i < 64; ++i) acc[i] = 0.f;
    u32x4 ua[4], va[4], ub[4], vb[4];
    { const int idx = __builtin_amdgcn_readfirstlane(s_idx[0]);
#pragma unroll
      for (int i = 0; i < 4; ++i) { ua[i] = *(const u32x4*)(EU + (size_t)idx * 4096 + 16 * (lane + 64 * i)); va[i] = *(const u32x4*)(EV + (size_t)idx * 4096 + 16 * (lane + 64 * i)); } }
#pragma unroll 1
    for (int k = 0; k < 128; k += 2) {
      const int idxb = __builtin_amdgcn_readfirstlane(s_idx[k + 1]);
#pragma unroll
      for (int i = 0; i < 4; ++i) { ub[i] = *(const u32x4*)(EU + (size_t)idxb * 4096 + 16 * (lane + 64 * i)); vb[i] = *(const u32x4*)(EV + (size_t)idxb * 4096 + 16 * (lane + 64 * i)); }
      { const int idx = __builtin_amdgcn_readfirstlane(s_idx[k]); const float gt = s_gate[k];
        float dot = 0.f; peer_fma(ua, hv, dot);
        dot = wave_sum_fast(dot) * SU[idx];
        const float act = dot / (1.f + __expf(-1.5957691216057308f * (dot + 0.044715f * dot * dot * dot)));
        peer_axpy(va, gt * act * SV[idx], acc); }
      if (k + 2 < 128) {
        const int idxa = __builtin_amdgcn_readfirstlane(s_idx[k + 2]);
#pragma unroll
        for (int i = 0; i < 4; ++i) { ua[i] = *(const u32x4*)(EU + (size_t)idxa * 4096 + 16 * (lane + 64 * i)); va[i] = *(const u32x4*)(EV + (size_t)idxa * 4096 + 16 * (lane + 64 * i)); }
      }
      { const float gt = s_gate[k + 1];
        float dot = 0.f; peer_fma(ub, hv, dot);
        dot = wave_sum_fast(dot) * SU[idxb];
        const float act = dot / (1.f + __expf(-1.5957691216057308f * (dot + 0.044715f * dot * dot * dot)));
        peer_axpy(vb, gt * act * SV[idxb], acc); }
    }
    float4* op = (float4*)(p.out + (size_t)tt * D_);
#pragma unroll
    for (int i = 0; i < 4; ++i)
#pragma unroll
      for (int q = 0; q < 4; ++q) {
        float4 o = op[(lane + 64 * i) * 4 + q];
        o.x += acc[16 * i + 4 * q]; o.y += acc[16 * i + 4 * q + 1]; o.z += acc[16 * i + 4 * q + 2]; o.w += acc[16 * i + 4 * q + 3];
        op[(lane + 64 * i) * 4 + q] = o;
      }
  }
}


#define XB_TMO      128
#define XB_XCNT(j)  (256  + 64 * (j))
#define XB_XSUB(j)  (1280 + 64 * (j))
#define XB_XGEN(j)  (2304 + 64 * (j))
#define XB_TOP      3328
#define XB_TOPGEN   3392
#define XB_SPIN_CAP (1u << 18)
__device__ __forceinline__ unsigned xb_ld(unsigned* q)              { return __hip_atomic_load(q, __ATOMIC_RELAXED, __HIP_MEMORY_SCOPE_AGENT); }
__device__ __forceinline__ unsigned xb_add(unsigned* q, unsigned v) { return __hip_atomic_fetch_add(q, v, __ATOMIC_RELAXED, __HIP_MEMORY_SCOPE_AGENT); }
__device__ __forceinline__ unsigned xb_xcc_id() { return (unsigned)__builtin_amdgcn_s_getreg((3 << 11) | 20) & 0xFu; }
#define XB_SPIN(cond, bar) do { unsigned _sp = 0; while (cond) { __builtin_amdgcn_s_sleep(1); \
    if ((++_sp & 255u) == 0u) { if (xb_ld(&(bar)[XB_TMO])) break; if (_sp > XB_SPIN_CAP) { atomicAdd(&(bar)[XB_TMO], 1u); break; } } } } while (0)
struct XcdBarrier { unsigned* bar; unsigned x; volatile unsigned* st; };
__device__ __forceinline__ XcdBarrier xcd_barrier_post(unsigned* bar, volatile unsigned* st) {
  XcdBarrier b; b.bar = bar; b.x = xb_xcc_id(); b.st = st;
  if (threadIdx.x == 0) (void)xb_add(&bar[XB_XCNT(b.x)], 1u);
  return b;
}
__device__ __forceinline__ void xcd_barrier_complete(unsigned* bar, unsigned x, unsigned& nloc, unsigned& nx) {
  const unsigned G = gridDim.x * gridDim.y * gridDim.z;
  unsigned sum, cnt, mine, sp = 0u;
  for (;;) {
    sum = 0u; cnt = 0u; mine = 0u;
#pragma unroll
    for (unsigned j = 0; j < 16; ++j) { const unsigned c = xb_ld(&bar[XB_XCNT(j)]); sum += c; cnt += (c > 0u) ? 1u : 0u; mine = (j == x) ? c : mine; }
    if (sum == G) break;
    __builtin_amdgcn_s_sleep(1);
    if ((++sp & 255u) == 0u) { if (xb_ld(&bar[XB_TMO])) break; if (sp > XB_SPIN_CAP) { atomicAdd(&bar[XB_TMO], 1u); break; } }
  }
  nloc = mine > 0u ? mine : 1u; nx = cnt > 0u ? cnt : 1u;
}
__device__ __forceinline__ void xcd_barrier(const XcdBarrier& b) {
  asm volatile("s_waitcnt vmcnt(0)" ::: "memory");
  __syncthreads();
  if (threadIdx.x == 0) {
    unsigned* bar = b.bar;
    __builtin_amdgcn_s_waitcnt(0);
    unsigned nloc = b.st[0], nx = b.st[1];
    if (nloc == 0u) { xcd_barrier_complete(bar, b.x, nloc, nx); b.st[0] = nloc; b.st[1] = nx; }
    const unsigned old = xb_add(&bar[XB_XSUB(b.x)], 1u);
    const unsigned gen = old / nloc;
    if (old + 1u == (gen + 1u) * nloc) {
      __builtin_amdgcn_fence(__ATOMIC_RELEASE, "agent");
      asm volatile("s_waitcnt vmcnt(0)" ::: "memory");
      const unsigned og = xb_add(&bar[XB_TOP], 1u);
      const unsigned tg = og / nx;
      if (og + 1u == (tg + 1u) * nx) xb_add(&bar[XB_TOPGEN], 1u);
      else XB_SPIN(xb_ld(&bar[XB_TOPGEN]) == tg, bar);
      __builtin_amdgcn_fence(__ATOMIC_ACQUIRE, "agent");
      xb_add(&bar[XB_XGEN(b.x)], 1u);
      asm volatile("s_waitcnt vmcnt(0)" ::: "memory");
    } else {
      XB_SPIN(xb_ld(&bar[XB_XGEN(b.x)]) == gen, bar);
      __builtin_amdgcn_fence(__ATOMIC_ACQUIRE, "agent");
      asm volatile("s_waitcnt vmcnt(0)" ::: "memory");
    }
  }
  __syncthreads();
}

#ifndef PROBE_DUP
#define PROBE_DUP 0
#endif
#define RUN_PHASE(n) if (lo <= n && n < hi) { if (n > lo) xcd_barrier(xb); phase##n(p, smem); }
__global__ void __launch_bounds__(256, 2) fwd_megakernel(Params p) {
  extern __shared__ __attribute__((aligned(16))) unsigned char smem[];
  const int lo = (int)p.ph_lo, hi = (int)p.ph_hi;
  volatile unsigned* st = (volatile unsigned*)(smem + LDS_BYTES - 16);
  if (threadIdx.x < 2) st[threadIdx.x] = 0u;
  __syncthreads();
  XcdBarrier xb = xcd_barrier_post((unsigned*)(p.ws + OFF_BAR), st);
  if (hi > 1000) cg::this_grid().sync();
  RUN_PHASE(0) RUN_PHASE(1) RUN_PHASE(2) RUN_PHASE(3) RUN_PHASE(4) RUN_PHASE(5)
  RUN_PHASE(6) RUN_PHASE(7) RUN_PHASE(8) RUN_PHASE(9) RUN_PHASE(10)
}

extern "C" void kernel_launch(void* const* d_in, const int* in_sizes, int n_in, void* d_out, int out_size, void* d_ws, size_t ws_size,
                              hipStream_t stream) {
  static int grid_blocks = 0;
  if (!grid_blocks) {
    if (ws_size < OFF_END) { fprintf(stderr, "kernel_launch: workspace too small (%zu < %zu)\n", ws_size, (size_t)OFF_END); grid_blocks = -1; return; }
    int dev = 0, cus = 0, per_cu = 0;
    hipGetDevice(&dev);
    hipDeviceGetAttribute(&cus, hipDeviceAttributeMultiprocessorCount, dev);
    if (hipFuncSetAttribute((const void*)fwd_megakernel, hipFuncAttributeMaxDynamicSharedMemorySize, LDS_BYTES) != hipSuccess) { fprintf(stderr, "kernel_launch: hipFuncSetAttribute failed\n"); grid_blocks = -1; return; }
    hipOccupancyMaxActiveBlocksPerMultiprocessor(&per_cu, (const void*)fwd_megakernel, 256, LDS_BYTES);
    if (per_cu < 1) { fprintf(stderr, "kernel_launch: occupancy query returned %d\n", per_cu); per_cu = 1; }
    if (per_cu > 2) per_cu = 2;
    grid_blocks = cus * per_cu;
  }
  if (grid_blocks < 0) return;
  Params p{};
  p.x = (const float*)d_in[0]; p.pos = (const int*)d_in[1]; p.norm_mix = (const float*)d_in[2]; p.w_in = (const float*)d_in[3];
  p.q_a_norm = (const float*)d_in[4]; p.w_uq = (const float*)d_in[5]; p.kv_a_norm = (const float*)d_in[6]; p.w_ukv = (const float*)d_in[7];
  p.q_norm = (const float*)d_in[8]; p.k_norm = (const float*)d_in[9]; p.attn_out_norm = (const float*)d_in[10]; p.conv_w = (const float*)d_in[11];
  p.conv_b = (const float*)d_in[12]; p.a_log_f = (const float*)d_in[13]; p.a_log_b = (const float*)d_in[14]; p.dt_bias_f = (const float*)d_in[15];
  p.dt_bias_b = (const float*)d_in[16]; p.d_skip = (const float*)d_in[17]; p.ssm_out_norm = (const float*)d_in[18]; p.w_out = (const float*)d_in[19];
  p.norm_ffn = (const float*)d_in[20]; p.w_query = (const float*)d_in[21]; p.sub_keys = (const float*)d_in[22]; p.expert_u = (const float*)d_in[23];
  p.expert_v = (const float*)d_in[24];
  p.out = (float*)d_out; p.ws = (unsigned char*)d_ws;
#if ONE_LAUNCH
  p.ph_lo = 0; p.ph_hi = NPHASE;
  if (hipMemsetAsync((unsigned char*)d_ws + OFF_BAR, 0, BAR_BYTES, stream) != hipSuccess) { fprintf(stderr, "kernel_launch: hipMemsetAsync failed\n"); return; }
  void* args[] = {&p};
  hipError_t e = hipLaunchCooperativeKernel((const void*)fwd_megakernel, dim3(grid_blocks), dim3(256), args, LDS_BYTES, stream);
  if (e != hipSuccess) fprintf(stderr, "cooperative launch failed: %s (grid %d)\n", hipGetErrorString(e), grid_blocks);
#else
  for (int ph = 0; ph < NPHASE; ++ph) {
    p.ph_lo = ph; p.ph_hi = ph + 1;
    hipLaunchKernelGGL(fwd_megakernel, dim3(grid_blocks), dim3(256), LDS_BYTES, stream, p);
  }
#endif
}
```
